# Optimizing an MI355X kernel written in HIP

```python
import math
import jax, jax.numpy as jnp
from jax import lax
import numpy as np

D_MODEL = 1024
BATCH = 2
SEQ = 16384
DEPTH = 1
DEC_BATCH = 16
DEC_SEQ = 32
PAST_LEN = 1024

CHUNK = 64
HEAD_DIM = 64
N_HEADS_A = 4
N_HEADS_B = 8
WIDTH_A = N_HEADS_A * 2 * HEAD_DIM
WIDTH_B = N_HEADS_B * HEAD_DIM
MIX_WIDTH = WIDTH_A + WIDTH_B
IN_COLS = 3 * WIDTH_A + 3 * WIDTH_B
D_FF = 4 * D_MODEL
D_PLE = 256
N_BUCKETS = 32
MAX_DISTANCE = 128
BAND_CHUNKS = 8
WINDOW_B = BAND_CHUNKS * CHUNK
BAND_LEN = WINDOW_B + CHUNK
REL_CLIP = 128
Q_BLOCK = 128
EPS = 1e-6
SUBLN_EPS = 1e-5
NEG = -1e30

kernel_name = "hymba_diff_band_stream_step"


def rmsnorm(x, g, eps=EPS):
    xf = x.astype(jnp.float32)
    y = xf * lax.rsqrt(jnp.mean(xf * xf, axis=-1, keepdims=True) + eps)
    return (y * g.astype(jnp.float32)).astype(x.dtype)


def t5_bucket(rel):
    half = N_BUCKETS // 2
    n = -rel
    ret = jnp.where(n < 0, half, 0)
    n = jnp.abs(n)
    max_exact = half // 2
    nf = jnp.maximum(n, 1).astype(jnp.float32)
    large = max_exact + (jnp.log(nf / max_exact) / math.log(MAX_DISTANCE / max_exact)
                         * (half - max_exact)).astype(jnp.int32)
    large = jnp.minimum(large, half - 1)
    return ret + jnp.where(n < max_exact, n, large)


def t5_bias(table, rel):
    return jnp.transpose(table[t5_bucket(rel)].astype(jnp.float32), (2, 0, 1))


def clip_bias(table, rel):
    idx = jnp.clip(rel, -REL_CLIP, REL_CLIP) + REL_CLIP
    return jnp.transpose(table[idx].astype(jnp.float32), (2, 0, 1))


def split_proj(a, w_in):
    B, T = a.shape[:2]
    z = a @ w_in
    qa, ka, va, qb, kb, vb = jnp.split(
        z, [WIDTH_A, 2 * WIDTH_A, 3 * WIDTH_A, 3 * WIDTH_A + WIDTH_B, 3 * WIDTH_A + 2 * WIDTH_B], axis=-1)
    qa = qa.reshape(B, T, N_HEADS_A, 2, HEAD_DIM)
    ka = ka.reshape(B, T, N_HEADS_A, 2, HEAD_DIM)
    va = va.reshape(B, T, N_HEADS_A, 2 * HEAD_DIM)
    qb = qb.reshape(B, T, N_HEADS_B, HEAD_DIM)
    kb = kb.reshape(B, T, N_HEADS_B, HEAD_DIM)
    vb = vb.reshape(B, T, N_HEADS_B, HEAD_DIM)
    return qa, ka, va, qb, kb, vb


def diff_core(q, k, v, bias, mask, lam):
    s = jnp.einsum('bqhmd,bkhmd->bhmqk', q, k).astype(jnp.float32) * (HEAD_DIM ** -0.5) + bias[:, None]
    s = jnp.where(mask, s, NEG)
    p = jax.nn.softmax(s, axis=-1)
    w = p[:, :, 0] - lam * p[:, :, 1]
    return jnp.einsum('bhqk,bkhe->bqhe', w.astype(v.dtype), v)


def band_core(q, k, v, bias, mask):
    s = jnp.einsum('bqhd,bkhd->bhqk', q, k).astype(jnp.float32) * (HEAD_DIM ** -0.5) + bias[None]
    s = jnp.where(mask, s, NEG)
    p = jax.nn.softmax(s, axis=-1)
    return jnp.einsum('bhqk,bkhd->bqhd', p.astype(v.dtype), v)


def diff_attn_prompt(q, k, v, table, lam):
    B, S = q.shape[:2]
    kpos = jnp.arange(S)

    def block(bi):
        q0 = bi * Q_BLOCK
        qb = lax.dynamic_slice_in_dim(q, q0, Q_BLOCK, axis=1)
        qpos = q0 + jnp.arange(Q_BLOCK)
        mask = (kpos[None, :] // CHUNK) <= (qpos[:, None] // CHUNK)
        bias = t5_bias(table, kpos[None, :] - qpos[:, None])
        return diff_core(qb, k, v, bias, mask, lam)

    out = lax.map(block, jnp.arange(S // Q_BLOCK))
    return jnp.moveaxis(out, 0, 1).reshape(B, S, N_HEADS_A, 2 * HEAD_DIM)


def band_attn_prompt(q, k, v, table):
    B, S = q.shape[:2]
    pad = ((0, 0), (WINDOW_B, 0), (0, 0), (0, 0))
    kp = jnp.pad(k, pad)
    vp = jnp.pad(v, pad)
    j = jnp.arange(BAND_LEN)
    i = jnp.arange(CHUNK)
    bias = clip_bias(table, (j[None, :] - WINDOW_B) - i[:, None])

    def chunk(c):
        c0 = c * CHUNK
        qc = lax.dynamic_slice_in_dim(q, c0, CHUNK, axis=1)
        kc = lax.dynamic_slice_in_dim(kp, c0, BAND_LEN, axis=1)
        vc = lax.dynamic_slice_in_dim(vp, c0, BAND_LEN, axis=1)
        valid = (c0 - WINDOW_B + j) >= 0
        mask = jnp.broadcast_to(valid[None, :], (CHUNK, BAND_LEN))
        return band_core(qc, kc, vc, bias, mask)

    out = lax.map(chunk, jnp.arange(S // CHUNK))
    return jnp.moveaxis(out, 0, 1).reshape(B, S, N_HEADS_B, HEAD_DIM)


def diff_attn_sample(q, k_all, v_all, table, lam, past):
    Tn = q.shape[1]
    kpos = jnp.arange(k_all.shape[1])
    qpos = past + jnp.arange(Tn)
    mask = (kpos[None, :] // CHUNK) <= (qpos[:, None] // CHUNK)
    bias = t5_bias(table, kpos[None, :] - qpos[:, None])
    return diff_core(q, k_all, v_all, bias, mask, lam)


def band_attn_sample(q, k_all, v_all, table, past, cache_len):
    Tn = q.shape[1]
    kpos = jnp.concatenate([past - cache_len + jnp.arange(cache_len), past + jnp.arange(Tn)])
    qpos = past + jnp.arange(Tn)
    kc = kpos[None, :] // CHUNK
    qc = qpos[:, None] // CHUNK
    mask = (kc <= qc) & (kc >= qc - BAND_CHUNKS) & (kpos[None, :] >= 0)
    bias = clip_bias(table, kpos[None, :] - qpos[:, None])
    return band_core(q, k_all, v_all, bias, mask)


def merge(oa, ob, subln_g, out_norm_b, w_out, lam_init):
    B, T = oa.shape[:2]
    oa = rmsnorm(oa, subln_g, SUBLN_EPS) * (1.0 - lam_init)
    ob = rmsnorm(ob.reshape(B, T, WIDTH_B), out_norm_b)
    return jnp.concatenate([oa.reshape(B, T, WIDTH_A), ob], axis=-1) @ w_out


def ffn_ple(h, p, g_mlp, w_up, w_down, w_ple_gate, w_ple_proj):
    c = rmsnorm(h, g_mlp)
    h = h + jnp.square(jax.nn.relu(c @ w_up)) @ w_down
    return h + jax.nn.sigmoid(h @ w_ple_gate) * (p @ w_ple_proj)


def setup_inputs(seed: int = 0) -> dict:
    key = jax.random.key(seed)
    ks = jax.random.split(key, 32)
    f32 = jnp.float32
    nrm = lambda k, shape, s: jax.random.normal(k, shape, f32) * s
    cache_b_len = min(WINDOW_B, PAST_LEN)
    return {
        "x_prompt": nrm(ks[0], (BATCH, SEQ, D_MODEL), 1.0),
        "x_sample": nrm(ks[1], (DEC_BATCH, DEC_SEQ, D_MODEL), 1.0),
        "cache_a_k": nrm(ks[2], (DEPTH, DEC_BATCH, PAST_LEN, N_HEADS_A, 2, HEAD_DIM), 1.0),
        "cache_a_v": nrm(ks[3], (DEPTH, DEC_BATCH, PAST_LEN, N_HEADS_A, 2 * HEAD_DIM), 1.0),
        "cache_b_k": nrm(ks[4], (DEPTH, DEC_BATCH, cache_b_len, N_HEADS_B, HEAD_DIM), 1.0),
        "cache_b_v": nrm(ks[5], (DEPTH, DEC_BATCH, cache_b_len, N_HEADS_B, HEAD_DIM), 1.0),
        "p_prompt": nrm(ks[6], (DEPTH, BATCH, SEQ, D_PLE), 1.0),
        "p_sample": nrm(ks[7], (DEPTH, DEC_BATCH, DEC_SEQ, D_PLE), 1.0),
        "t5_table": nrm(ks[8], (N_BUCKETS, N_HEADS_A), 0.5),
        "g_attn": 1.0 + nrm(ks[9], (DEPTH, D_MODEL), 0.02),
        "w_in": nrm(ks[10], (DEPTH, D_MODEL, IN_COLS), D_MODEL ** -0.5),
        "lambda_q1": nrm(ks[11], (DEPTH, HEAD_DIM), 0.1),
        "lambda_k1": nrm(ks[12], (DEPTH, HEAD_DIM), 0.1),
        "lambda_q2": nrm(ks[13], (DEPTH, HEAD_DIM), 0.1),
        "lambda_k2": nrm(ks[14], (DEPTH, HEAD_DIM), 0.1),
        "subln_g": 1.0 + nrm(ks[15], (DEPTH, 2 * HEAD_DIM), 0.02),
        "band_table": nrm(ks[16], (DEPTH, 2 * REL_CLIP + 1, N_HEADS_B), 0.5),
        "out_norm_b": 1.0 + nrm(ks[17], (DEPTH, WIDTH_B), 0.02),
        "w_out": nrm(ks[18], (DEPTH, MIX_WIDTH, D_MODEL), MIX_WIDTH ** -0.5),
        "g_mlp": 1.0 + nrm(ks[19], (DEPTH, D_MODEL), 0.02),
        "w_up": nrm(ks[20], (DEPTH, D_MODEL, D_FF), D_MODEL ** -0.5),
        "w_down": nrm(ks[21], (DEPTH, D_FF, D_MODEL), D_FF ** -0.5),
        "w_ple_gate": nrm(ks[22], (DEPTH, D_MODEL, D_MODEL), D_MODEL ** -0.5),
        "w_ple_proj": nrm(ks[23], (DEPTH, D_PLE, D_MODEL), D_PLE ** -0.5),
        "g_final": 1.0 + nrm(ks[24], (D_MODEL,), 0.02),
    }


def reference(x_prompt, x_sample, cache_a_k, cache_a_v, cache_b_k, cache_b_v, p_prompt, p_sample,
              t5_table, g_attn, w_in, lambda_q1, lambda_k1, lambda_q2, lambda_k2, subln_g,
              band_table, out_norm_b, w_out, g_mlp, w_up, w_down, w_ple_gate, w_ple_proj, g_final):
    hp, hs = x_prompt, x_sample
    S = hp.shape[1]
    past = cache_a_k.shape[2]
    cache_b_len = cache_b_k.shape[2]
    keep = min(WINDOW_B, S)
    ak_p, av_p, bk_p, bv_p = [], [], [], []
    ak_s, av_s, bk_s, bv_s = [], [], [], []
    for i in range(DEPTH):
        lam_init = 0.8 - 0.6 * math.exp(-0.3 * i)
        lam = (jnp.exp(jnp.sum(lambda_q1[i].astype(jnp.float32) * lambda_k1[i].astype(jnp.float32)))
               - jnp.exp(jnp.sum(lambda_q2[i].astype(jnp.float32) * lambda_k2[i].astype(jnp.float32)))
               + lam_init)
        qa, ka, va, qb, kb, vb = split_proj(rmsnorm(hp, g_attn[i]), w_in[i])
        oa = diff_attn_prompt(qa, ka, va, t5_table, lam)
        ob = band_attn_prompt(qb, kb, vb, band_table[i])
        hp = hp + merge(oa, ob, subln_g[i], out_norm_b[i], w_out[i], lam_init)
        hp = ffn_ple(hp, p_prompt[i], g_mlp[i], w_up[i], w_down[i], w_ple_gate[i], w_ple_proj[i])
        ak_p.append(ka)
        av_p.append(va)
        bk_p.append(kb[:, S - keep:])
        bv_p.append(vb[:, S - keep:])
        qa, ka, va, qb, kb, vb = split_proj(rmsnorm(hs, g_attn[i]), w_in[i])
        ka_all = jnp.concatenate([cache_a_k[i], ka], axis=1)
        va_all = jnp.concatenate([cache_a_v[i], va], axis=1)
        kb_all = jnp.concatenate([cache_b_k[i], kb], axis=1)
        vb_all = jnp.concatenate([cache_b_v[i], vb], axis=1)
        oa = diff_attn_sample(qa, ka_all, va_all, t5_table, lam, past)
        ob = band_attn_sample(qb, kb_all, vb_all, band_table[i], past, cache_b_len)
        hs = hs + merge(oa, ob, subln_g[i], out_norm_b[i], w_out[i], lam_init)
        hs = ffn_ple(hs, p_sample[i], g_mlp[i], w_up[i], w_down[i], w_ple_gate[i], w_ple_proj[i])
        ak_s.append(ka)
        av_s.append(va)
        bk_s.append(kb)
        bv_s.append(vb)
    y_prompt = rmsnorm(hp, g_final)
    y_sample = rmsnorm(hs, g_final)
    return (y_prompt, y_sample,
            jnp.stack(ak_p), jnp.stack(av_p), jnp.stack(bk_p), jnp.stack(bv_p),
            jnp.stack(ak_s), jnp.stack(av_s), jnp.stack(bk_s), jnp.stack(bv_s))
```

```cpp
#include <hip/hip_runtime.h>
#include <hip/hip_cooperative_groups.h>
#include <hip/hip_bf16.h>
#include <cstdio>
#include <cstdint>
namespace cg = cooperative_groups;

constexpr int DM = 1024, SEQ = 16384, NB = 2, MP = NB * SEQ  , SB = 16, SS = 32, MS = SB * SS  , MT = MP + MS  ;
constexpr int PAST = 1024, CBL = 512, NZ = 3072, DFF = 4096, DPLE = 256;
constexpr float LOG2E = 1.4426950408889634f, C2 = 0.125f * LOG2E;
constexpr size_t O_Y = 0, O_AKP = (size_t)MT * DM, O_AVP = O_AKP + (size_t)MP * 512, O_BKP = O_AVP + (size_t)MP * 512, O_BVP = O_BKP + (size_t)NB * 512 * 512,
                 O_AKS = O_BVP + (size_t)NB * 512 * 512, O_AVS = O_AKS + (size_t)MS * 512, O_BKS = O_AVS + (size_t)MS * 512, O_BVS = O_BKS + (size_t)MS * 512, O_END = O_BVS + (size_t)MS * 512;

namespace pg8 {
#define PG8_LAS __attribute__((address_space(3)))
typedef unsigned short bf16_t;
typedef short bf16x8 __attribute__((ext_vector_type(8)));
typedef float f32x4 __attribute__((ext_vector_type(4)));
typedef unsigned u32x4 __attribute__((ext_vector_type(4)));
constexpr int BM = 256, BK = 64, HALF = 128, HTB = HALF * BK * 2  , STAGE_BYTES = 8 * HTB, NXCD = 8, WGM = 8;

__host__ __device__ __forceinline__ int lds_byte(int r, int c) { const int st = (r >> 4) * 2 + (c >> 5), rr = r & 15, cc = c & 31, ob = rr * 64 + cc * 2; return st * 1024 + (ob ^ (((ob >> 9) & 1) << 5)); }
__host__ __device__ __forceinline__ void stage_rc(int b, int& R, int& C) { const int st = b / 1024, sb = b % 1024, swz = sb ^ (((sb >> 9) & 1) << 5); R = (st >> 1) * 16 + swz / 64; C = (st & 1) * 32 + (swz % 64) / 2; }
__host__ __device__ __forceinline__ int perm32(int rho) { const int n = rho >> 4, i = rho & 15; return 8 * (i >> 2) + 4 * n + (i & 3); }

struct Unit { int pm, pn; };
struct Gemm { const bf16_t* A; const bf16_t* Bt; int M, N, K; };

struct StaticOrder {
    int nM, nN, nwg, G, c;
    __host__ __device__ void init(int M, int N, int G_, int c_) { nM = M / BM; nN = N / BM; nwg = nM * nN; G = G_; c = c_; }
    __host__ __device__ bool next(int i, Unit& u) const {
        const long L = (long)i * G + c; if (L >= nwg) return false;
        int wgid = (int)L; { const int q = nwg / NXCD, r = nwg % NXCD, xcd = wgid % NXCD, off = wgid / NXCD; wgid = (xcd < r ? xcd * (q + 1) : r * (q + 1) + (xcd - r) * q) + off; }
        const int nig = WGM * nN, gid = wgid / nig, fm = gid * WGM, gsz = (nM - fm) < WGM ? (nM - fm) : WGM;
        u.pm = fm + ((wgid % nig) % gsz); u.pn = (wgid % nig) / gsz; return true;
    }
    __device__ __forceinline__ void a_ready(const Unit&) const {}
    __device__ __forceinline__ void done(const Unit&) const {}
};


typedef float f32x2 __attribute__((ext_vector_type(2)));
typedef __bf16 bf16x2_t __attribute__((ext_vector_type(2)));
__device__ __forceinline__ unsigned cvt_pk_bf16(float lo, float hi) { f32x2 v = {lo, hi}; bf16x2_t b = __builtin_convertvector(v, bf16x2_t); return __builtin_bit_cast(unsigned, b); }
__device__ __forceinline__ int lane_late() { int ln; asm volatile("v_mbcnt_lo_u32_b32 %0, -1, 0\n\tv_mbcnt_hi_u32_b32 %0, -1, %0" : "=v"(ln)); return ln; }
__device__ __forceinline__ u32x4 pack8(const f32x4& a, const f32x4& b) { u32x4 w; w.x = cvt_pk_bf16(a[0], a[1]); w.y = cvt_pk_bf16(a[2], a[3]); w.z = cvt_pk_bf16(b[0], b[1]); w.w = cvt_pk_bf16(b[2], b[3]); return w; }

struct EpiQKV {
    static constexpr bool PERM = true, AFTER_DRAIN = false;
    bf16_t* Z; float* out;
    __device__ __forceinline__ void operator()(const f32x4 (&acc)[2][2][4][2], const Unit& u, int wr, int wc, int fr, int fq) const {
        { const int ln_ = lane_late(); fr = ln_ & 15; fq = ln_ >> 4; }
        const int seg = u.pn >> 1;
        const float sc = (seg == 0 || seg == 3) ? C2 : 1.0f;
        const int row0 = u.pm * BM + wr * 64 + fr, col0 = u.pn * BM + wc * 32 + 8 * fq, cs0 = col0 - seg * 512;
#pragma unroll
        for (int ai = 0; ai < 2; ++ai)
#pragma unroll
            for (int m = 0; m < 4; ++m) {
                const int row = row0 + ai * HALF + m * 16;
                bf16_t* zp = Z + (size_t)row * NZ + col0;
                float* fp = nullptr;
                if (seg == 1 || seg == 2 || seg == 4 || seg == 5) {
                    if (row < MP) {
                        if (seg == 1) fp = out + O_AKP + (size_t)row * 512;
                        else if (seg == 2) fp = out + O_AVP + (size_t)row * 512;
                        else { const int t = row & (SEQ - 1), b = row >> 14; if (t >= SEQ - 512) fp = out + (seg == 4 ? O_BKP : O_BVP) + (size_t)(b * 512 + t - (SEQ - 512)) * 512; }
                    } else {
                        const int rs = row - MP;
                        fp = out + (seg == 1 ? O_AKS : seg == 2 ? O_AVS : seg == 4 ? O_BKS : O_BVS) + (size_t)rs * 512;
                    }
                }
#pragma unroll
                for (int bj = 0; bj < 2; ++bj) {
                    const f32x4 v0 = acc[ai][bj][m][0], v1 = acc[ai][bj][m][1];
                    *(u32x4*)(zp + bj * HALF) = pack8(v0 * sc, v1 * sc);
                    if (fp) { *(f32x4*)(fp + cs0 + bj * HALF) = v0; *(f32x4*)(fp + cs0 + bj * HALF + 4) = v1; }
                }
            }
    }
};
struct EpiOut {
    static constexpr bool PERM = true, AFTER_DRAIN = false;
    const float* xp; const float* xs; float* Y; bf16_t* HB; float* SSQ;
    __device__ __forceinline__ void operator()(const f32x4 (&acc)[2][2][4][2], const Unit& u, int wr, int wc, int fr, int fq) const {
        { const int ln_ = lane_late(); fr = ln_ & 15; fq = ln_ >> 4; }
        const int row0 = u.pm * BM + wr * 64 + fr, col0 = u.pn * BM + wc * 32 + 8 * fq;
#pragma unroll
        for (int ai = 0; ai < 2; ++ai)
#pragma unroll
            for (int m = 0; m < 4; ++m) {
                const int row = row0 + ai * HALF + m * 16;
                const float* xr = (row < MP ? xp + (size_t)row * DM : xs + (size_t)(row - MP) * DM) + col0;
                float ss = 0.f;
#pragma unroll
                for (int bj = 0; bj < 2; ++bj) {
                    const f32x4 h0 = *(const f32x4*)(xr + bj * HALF) + acc[ai][bj][m][0], h1 = *(const f32x4*)(xr + bj * HALF + 4) + acc[ai][bj][m][1];
                    float* yp = Y + (size_t)row * DM + col0 + bj * HALF; *(f32x4*)yp = h0; *(f32x4*)(yp + 4) = h1;
                    *(u32x4*)(HB + (size_t)row * DM + col0 + bj * HALF) = pack8(h0, h1);
                    ss += (h0[0] * h0[0] + h0[1] * h0[1]) + (h0[2] * h0[2] + h0[3] * h0[3]) + (h1[0] * h1[0] + h1[1] * h1[1]) + (h1[2] * h1[2] + h1[3] * h1[3]);
                }
                ss += __shfl_xor(ss, 16); ss += __shfl_xor(ss, 32);
                if (fq == 0) SSQ[(size_t)row * 16 + u.pn * 4 + wc] = ss;
            }
    }
};
struct EpiUp {
    static constexpr bool PERM = true, AFTER_DRAIN = false;
    bf16_t* U; const float* SSQ;
    __device__ __forceinline__ void operator()(const f32x4 (&acc)[2][2][4][2], const Unit& u, int wr, int wc, int fr, int fq) const {
        { const int ln_ = lane_late(); fr = ln_ & 15; fq = ln_ >> 4; }
        const int row0 = u.pm * BM + wr * 64 + fr, col0 = u.pn * BM + wc * 32 + 8 * fq;
#pragma unroll
        for (int ai = 0; ai < 2; ++ai)
#pragma unroll
            for (int m = 0; m < 4; ++m) {
                const int row = row0 + ai * HALF + m * 16;
                const f32x4 s0 = ((const f32x4*)(SSQ + (size_t)row * 16))[fq];
                float tot = (s0[0] + s0[1]) + (s0[2] + s0[3]);
                tot += __shfl_xor(tot, 16); tot += __shfl_xor(tot, 32);
                const float rstd = 1.0f / sqrtf(tot * (1.0f / DM) + 1e-6f);
#pragma unroll
                for (int bj = 0; bj < 2; ++bj) {
                    f32x4 v0 = acc[ai][bj][m][0] * rstd, v1 = acc[ai][bj][m][1] * rstd;
#pragma unroll
                    for (int j = 0; j < 4; ++j) { const float a = fmaxf(v0[j], 0.f), b = fmaxf(v1[j], 0.f); v0[j] = a * a; v1[j] = b * b; }
                    *(u32x4*)(U + (size_t)row * DFF + col0 + bj * HALF) = pack8(v0, v1);
                }
            }
    }
};
struct EpiPP {
    static constexpr bool PERM = true, AFTER_DRAIN = false;
    bf16_t* PP;
    __device__ __forceinline__ void operator()(const f32x4 (&acc)[2][2][4][2], const Unit& u, int wr, int wc, int fr, int fq) const {
        { const int ln_ = lane_late(); fr = ln_ & 15; fq = ln_ >> 4; }
        const int row0 = u.pm * BM + wr * 64 + fr, col0 = u.pn * BM + wc * 32 + 8 * fq;
#pragma unroll
        for (int ai = 0; ai < 2; ++ai)
#pragma unroll
            for (int m = 0; m < 4; ++m) {
                const int row = row0 + ai * HALF + m * 16;
#pragma unroll
                for (int bj = 0; bj < 2; ++bj) *(u32x4*)(PP + (size_t)row * DM + col0 + bj * HALF) = pack8(acc[ai][bj][m][0], acc[ai][bj][m][1]);
            }
    }
};
struct EpiDown {
    static constexpr bool PERM = true, AFTER_DRAIN = false;
    float* Y; bf16_t* HB;
    __device__ __forceinline__ void operator()(const f32x4 (&acc)[2][2][4][2], const Unit& u, int wr, int wc, int fr, int fq) const {
        { const int ln_ = lane_late(); fr = ln_ & 15; fq = ln_ >> 4; }
        const int row0 = u.pm * BM + wr * 64 + fr, col0 = u.pn * BM + wc * 32 + 8 * fq;
#pragma unroll
        for (int ai = 0; ai < 2; ++ai)
#pragma unroll
            for (int m = 0; m < 4; ++m) {
                const int row = row0 + ai * HALF + m * 16;
#pragma unroll
                for (int bj = 0; bj < 2; ++bj) {
                    float* yp = Y + (size_t)row * DM + col0 + bj * HALF;
                    const f32x4 h0 = *(const f32x4*)yp + acc[ai][bj][m][0], h1 = *(const f32x4*)(yp + 4) + acc[ai][bj][m][1];
                    *(f32x4*)yp = h0; *(f32x4*)(yp + 4) = h1;
                    *(u32x4*)(HB + (size_t)row * DM + col0 + bj * HALF) = pack8(h0, h1);
                }
            }
    }
};
struct EpiGate {
    static constexpr bool PERM = true, AFTER_DRAIN = false;
    float* Y; const bf16_t* PP; float* SSQ;
    __device__ __forceinline__ void operator()(const f32x4 (&acc)[2][2][4][2], const Unit& u, int wr, int wc, int fr, int fq) const {
        { const int ln_ = lane_late(); fr = ln_ & 15; fq = ln_ >> 4; }
        const int row0 = u.pm * BM + wr * 64 + fr, col0 = u.pn * BM + wc * 32 + 8 * fq;
#pragma unroll
        for (int ai = 0; ai < 2; ++ai)
#pragma unroll
            for (int m = 0; m < 4; ++m) {
                const int row = row0 + ai * HALF + m * 16;
                float ss = 0.f;
#pragma unroll
                for (int bj = 0; bj < 2; ++bj) {
                    float* yp = Y + (size_t)row * DM + col0 + bj * HALF;
                    const u32x4 pw = *(const u32x4*)(PP + (size_t)row * DM + col0 + bj * HALF);
                    f32x4 p0, p1;
                    p0[0] = __uint_as_float(pw.x << 16); p0[1] = __uint_as_float(pw.x & 0xffff0000u); p0[2] = __uint_as_float(pw.y << 16); p0[3] = __uint_as_float(pw.y & 0xffff0000u);
                    p1[0] = __uint_as_float(pw.z << 16); p1[1] = __uint_as_float(pw.z & 0xffff0000u); p1[2] = __uint_as_float(pw.w << 16); p1[3] = __uint_as_float(pw.w & 0xffff0000u);
                    f32x4 h0 = *(const f32x4*)yp, h1 = *(const f32x4*)(yp + 4);
                    const f32x4 a0 = acc[ai][bj][m][0], a1 = acc[ai][bj][m][1];
#pragma unroll
                    for (int j = 0; j < 4; ++j) {
                        const float g0 = __builtin_amdgcn_rcpf(1.0f + __builtin_amdgcn_exp2f(-LOG2E * a0[j])), g1 = __builtin_amdgcn_rcpf(1.0f + __builtin_amdgcn_exp2f(-LOG2E * a1[j]));
                        h0[j] += g0 * p0[j]; h1[j] += g1 * p1[j];
                    }
                    *(f32x4*)yp = h0; *(f32x4*)(yp + 4) = h1;
                    ss += (h0[0] * h0[0] + h0[1] * h0[1]) + (h0[2] * h0[2] + h0[3] * h0[3]) + (h1[0] * h1[0] + h1[1] * h1[1]) + (h1[2] * h1[2] + h1[3] * h1[3]);
                }
                ss += __shfl_xor(ss, 16); ss += __shfl_xor(ss, 32);
                if (fq == 0) SSQ[(size_t)row * 16 + u.pn * 4 + wc] = ss;
            }
    }
};

template <class Epi, class Sched, bool ALIGN_EPI = false, bool SP2 = false>
__device__ __forceinline__ void gemm_phase(PG8_LAS unsigned char* lds, const Gemm g, const Sched& S, const Epi& E, const int wave_s  ) {
    const int wid = wave_s, lane = lane_late(), tid = wid * 64 + lane, wr = wid >> 2, wc = wid & 3, fr = lane & 15, fq = lane >> 4;
    const int K = g.K, nt = K / BK;
    unsigned voffA[2], voffB[2];
#pragma unroll
    for (int i = 0; i < 2; ++i) { int R, C; stage_rc(tid * 16 + i * 8192, R, C); const int Rb = Epi::PERM ? ((R & ~31) + perm32(R & 31)) : R;
        voffA[i] = (unsigned)(R * K + C) * 2u; voffB[i] = (unsigned)(Rb * K + C) * 2u; }
    const size_t kstep = (size_t)(BK * 2);
    const size_t hstep = (size_t)HALF * K * 2;
    const size_t tstep = 2 * hstep;
    const unsigned ldsw = (unsigned)wid * 1024u;
    const int aoff = lds_byte(wr * 64 + fr, fq * 8), boff = lds_byte(wc * 32 + fr, fq * 8);
#define PG8_SA(b, h) (((b) * 2 + (h)) * HTB)
#define PG8_SB(b, h) ((4 + (b) * 2 + (h)) * HTB)
#define PG8_STAGE(bufoff, gbase, voff) do { _Pragma("unroll") for (int _i = 0; _i < 2; ++_i) \
        __builtin_amdgcn_global_load_lds((const unsigned*)((const char*)(gbase) + (voff)[_i]), (PG8_LAS unsigned*)(lds + (bufoff) + ldsw + _i * 8192), 16, 0, 0); } while (0)
#define PG8_LDA(dst, b, h) do { _Pragma("unroll") for (int m = 0; m < 4; ++m) _Pragma("unroll") for (int k = 0; k < 2; ++k) dst[m][k] = *(const PG8_LAS bf16x8*)(lds + PG8_SA(b, h) + aoff + m * 2048 + k * 1024); } while (0)
#define PG8_LDB(dst, b, h) do { _Pragma("unroll") for (int n = 0; n < 2; ++n) _Pragma("unroll") for (int k = 0; k < 2; ++k) dst[n][k] = *(const PG8_LAS bf16x8*)(lds + PG8_SB(b, h) + boff + n * 2048 + k * 1024); } while (0)
#define PG8_MMA(ai, bj, At, Bt) do { __builtin_amdgcn_s_setprio(1); _Pragma("unroll") for (int m = 0; m < 4; ++m) _Pragma("unroll") for (int n = 0; n < 2; ++n) _Pragma("unroll") for (int k = 0; k < 2; ++k) \
        acc[ai][bj][m][n] = __builtin_amdgcn_mfma_f32_16x16x32_bf16(Bt[n][k], At[m][k], acc[ai][bj][m][n], 0, 0, 0); __builtin_amdgcn_s_setprio(0); } while (0)
#define PG8_WAIT_V(n) asm volatile("s_waitcnt vmcnt(" #n ")" ::: "memory")
#define PG8_WAIT_L(n) asm volatile("s_waitcnt lgkmcnt(" #n ")" ::: "memory")
#define PG8_BAR __builtin_amdgcn_s_barrier()
#define PG8_SCHED __builtin_amdgcn_sched_barrier(0)
    Unit cur, nxt; int ui = 0;
    if (!S.next(0, cur)) return;
    f32x4 acc[2][2][4][2];
#pragma unroll
    for (int a = 0; a < 2; ++a)
#pragma unroll
        for (int b = 0; b < 2; ++b)
#pragma unroll
            for (int m = 0; m < 4; ++m)
#pragma unroll
                for (int n = 0; n < 2; ++n) acc[a][b][m][n] = (f32x4){0.f, 0.f, 0.f, 0.f};
    bf16x8 At[4][2], B0[2][2], B1[2][2];
    const char* cA = (const char*)g.A + (size_t)cur.pm * tstep; const char* cB = (const char*)g.Bt + (size_t)cur.pn * tstep;
    S.a_ready(cur);
    if constexpr (SP2) {
        PG8_STAGE(PG8_SB(0, 0), cB, voffB); PG8_STAGE(PG8_SB(0, 1), cB + hstep, voffB); PG8_STAGE(PG8_SA(0, 0), cA, voffA); PG8_STAGE(PG8_SA(0, 1), cA + hstep, voffA);
        if (wr == 1) PG8_BAR;
        PG8_WAIT_V(2); PG8_BAR;
        PG8_STAGE(PG8_SB(1, 0), cB + kstep, voffB); PG8_STAGE(PG8_SA(1, 0), cA + kstep, voffA); PG8_STAGE(PG8_SB(1, 1), cB + hstep + kstep, voffB);
        PG8_WAIT_V(6); PG8_BAR;
    } else {
        PG8_STAGE(PG8_SB(0, 0), cB, voffB); PG8_STAGE(PG8_SA(0, 0), cA, voffA); PG8_STAGE(PG8_SB(0, 1), cB + hstep, voffB); PG8_STAGE(PG8_SA(0, 1), cA + hstep, voffA);
        if (wr == 1) PG8_BAR;
        PG8_WAIT_V(4); PG8_BAR;
        PG8_STAGE(PG8_SB(1, 0), cB + kstep, voffB); PG8_STAGE(PG8_SA(1, 0), cA + kstep, voffA); PG8_STAGE(PG8_SB(1, 1), cB + hstep + kstep, voffB);
        PG8_WAIT_V(6); PG8_BAR;
    }
    for (;;) {
        const bool has_next = S.next(ui + 1, nxt);
        const char* nA = has_next ? (const char*)g.A + (size_t)nxt.pm * tstep : cA; const char* nB = has_next ? (const char*)g.Bt + (size_t)nxt.pn * tstep : cB;
        for (int t = 0; t < nt; t += 2) {
            const bool last = (t == nt - 2);
            const char* a1 = cA + (size_t)(t + 1) * kstep;
            const char* a2 = last ? nA : cA + (size_t)(t + 2) * kstep; const char* b2 = last ? nB : cB + (size_t)(t + 2) * kstep;
            const char* a3 = a2 + kstep; const char* b3 = b2 + kstep;
            if (last && has_next) S.a_ready(nxt);
            if constexpr (SP2) {
            PG8_LDB(B0, 0, 0); PG8_LDB(B1, 0, 1); PG8_SCHED; PG8_LDA(At, 0, 0); PG8_STAGE(PG8_SA(1, 1), a1 + hstep, voffA);
            PG8_WAIT_V(8); PG8_WAIT_L(0); PG8_BAR; PG8_MMA(0, 0, At, B0); PG8_MMA(0, 1, At, B1); PG8_BAR; PG8_SCHED;
            PG8_LDA(At, 0, 1); PG8_STAGE(PG8_SB(0, 0), b2, voffB); PG8_STAGE(PG8_SB(0, 1), b2 + hstep, voffB); PG8_STAGE(PG8_SA(0, 0), a2, voffA);
            PG8_WAIT_V(8); PG8_WAIT_L(0); PG8_BAR; PG8_MMA(1, 0, At, B0); PG8_MMA(1, 1, At, B1); PG8_BAR; PG8_SCHED;
            PG8_LDB(B0, 1, 0); PG8_LDB(B1, 1, 1); PG8_SCHED; PG8_LDA(At, 1, 0); PG8_STAGE(PG8_SA(0, 1), a2 + hstep, voffA);
            PG8_WAIT_V(8); PG8_WAIT_L(0); PG8_BAR; PG8_MMA(0, 0, At, B0); PG8_MMA(0, 1, At, B1); PG8_BAR; PG8_SCHED;
            PG8_LDA(At, 1, 1); PG8_STAGE(PG8_SB(1, 0), b3, voffB); PG8_STAGE(PG8_SB(1, 1), b3 + hstep, voffB); PG8_STAGE(PG8_SA(1, 0), a3, voffA);
            PG8_WAIT_V(8); PG8_WAIT_L(0); PG8_BAR; PG8_MMA(1, 0, At, B0); PG8_MMA(1, 1, At, B1); PG8_BAR; PG8_SCHED;
            } else {
            PG8_LDB(B0, 0, 0); PG8_SCHED; PG8_LDA(At, 0, 0); PG8_STAGE(PG8_SA(1, 1), a1 + hstep, voffA);
            PG8_WAIT_L(8); PG8_BAR; PG8_WAIT_L(0); PG8_MMA(0, 0, At, B0); PG8_BAR; PG8_SCHED;
            PG8_LDB(B1, 0, 1); PG8_STAGE(PG8_SB(0, 0), b2, voffB);
            PG8_BAR; PG8_WAIT_L(0); PG8_MMA(0, 1, At, B1); PG8_BAR;
            PG8_LDA(At, 0, 1); PG8_STAGE(PG8_SA(0, 0), a2, voffA);
            PG8_BAR; PG8_WAIT_L(0); PG8_MMA(1, 0, At, B0); PG8_BAR; PG8_SCHED;
            PG8_STAGE(PG8_SB(0, 1), b2 + hstep, voffB);
            PG8_WAIT_V(6); PG8_BAR; PG8_MMA(1, 1, At, B1); PG8_BAR;
            PG8_LDB(B0, 1, 0); PG8_SCHED; PG8_LDA(At, 1, 0); PG8_STAGE(PG8_SA(0, 1), a2 + hstep, voffA);
            PG8_WAIT_L(8); PG8_BAR; PG8_WAIT_L(0); PG8_MMA(0, 0, At, B0); PG8_BAR; PG8_SCHED;
            PG8_LDB(B1, 1, 1); PG8_STAGE(PG8_SB(1, 0), b3, voffB);
            PG8_BAR; PG8_WAIT_L(0); PG8_MMA(0, 1, At, B1); PG8_BAR;
            PG8_LDA(At, 1, 1); PG8_STAGE(PG8_SA(1, 0), a3, voffA);
            PG8_BAR; PG8_WAIT_L(0); PG8_MMA(1, 0, At, B0); PG8_BAR; PG8_SCHED;
            PG8_STAGE(PG8_SB(1, 1), b3 + hstep, voffB);
            PG8_WAIT_V(6); PG8_BAR; PG8_MMA(1, 1, At, B1); PG8_BAR;
            }
        }
        if constexpr (ALIGN_EPI) { if (wr == 0) PG8_BAR; }
        if constexpr (!Epi::AFTER_DRAIN) { E(acc, cur, wr, wc, fr, fq); S.done(cur); }
        if (!has_next) break;
#pragma unroll
        for (int a = 0; a < 2; ++a)
#pragma unroll
            for (int b = 0; b < 2; ++b)
#pragma unroll
                for (int m = 0; m < 4; ++m)
#pragma unroll
                    for (int n = 0; n < 2; ++n) acc[a][b][m][n] = (f32x4){0.f, 0.f, 0.f, 0.f};
        cur = nxt; cA = nA; cB = nB; ++ui;
        if constexpr (ALIGN_EPI) { if (wr == 1) PG8_BAR; }
    }
    PG8_WAIT_V(0);
    if constexpr (!ALIGN_EPI) { if (wr == 0) PG8_BAR; }
    PG8_BAR;
    if constexpr (Epi::AFTER_DRAIN) { E.fused(acc, cur, wr, wc, fr, fq, lds, wid, lane); S.done(cur); }
#undef PG8_SA
#undef PG8_SB
#undef PG8_STAGE
#undef PG8_LDA
#undef PG8_LDB
#undef PG8_MMA
#undef PG8_WAIT_V
#undef PG8_WAIT_L
#undef PG8_BAR
#undef PG8_SCHED
}
}

namespace att {
#define LAS __attribute__((address_space(3)))
typedef unsigned short bf16_t;
typedef short bf16x8 __attribute__((ext_vector_type(8)));
typedef short s16x4 __attribute__((ext_vector_type(4)));
typedef short v4i16_t __attribute__((ext_vector_type(4)));
typedef float f32x16 __attribute__((ext_vector_type(16)));
typedef float f32x4 __attribute__((ext_vector_type(4)));
typedef unsigned u32x4 __attribute__((ext_vector_type(4)));
typedef LAS unsigned char* ldsp;
typedef const LAS unsigned char* ldscp;
constexpr float THR = 8.0f;
constexpr float NEGBIG = -1.0e30f;
constexpr int L_T5 = 131072;
constexpr int L_BT = L_T5 + 8192;
constexpr int L_WSF = L_BT + 8448;
constexpr int L_XCH = L_WSF + 2048;
constexpr int L_END = L_XCH + 2048;

__device__ __forceinline__ int crow(int r, int hi) { return (r & 3) + 8 * (r >> 2) + 4 * hi; }
__device__ __forceinline__ constexpr int crow0(int r) { return (r & 3) + 8 * (r >> 2); }
__device__ __forceinline__ unsigned cvtpk(float lo, float hi) { return pg8::cvt_pk_bf16(lo, hi); }
__device__ __forceinline__ s16x4 vtr(ldscp p) { return __builtin_bit_cast(s16x4, __builtin_amdgcn_ds_read_tr16_b64_v4i16((LAS v4i16_t*)p)); }
__device__ __forceinline__ float hmax32(float m) { return fmaxf(m, __shfl_xor(m, 32)); }
__device__ __forceinline__ u32x4 cvt8(const f32x4& a, const f32x4& b) { return pg8::pack8(a, b); }
__device__ __forceinline__ int t5_bucket(int rel) {
    int n = -rel; const int ret = n < 0 ? 16 : 0; n = n < 0 ? -n : n;
    if (n < 8) return ret + n;
    return ret + 8 + (n >= 12) + (n >= 16) + (n >= 23) + (n >= 32) + (n >= 46) + (n >= 64) + (n >= 91);
}

__device__ __forceinline__ void qkt(f32x16& p0, f32x16& p1, ldscp Kslot, const bf16x8* qr, const f32x16& cinit, int r32, int hi) {
    ldscp kb = Kslot + hi * 1024 + r32 * 16;
#pragma unroll
    for (int d0 = 0; d0 < 4; ++d0) {
        const bf16x8 b0 = *(const LAS bf16x8*)(kb + d0 * 2048);
        const bf16x8 b1 = *(const LAS bf16x8*)(kb + d0 * 2048 + 512);
        if (d0 == 0) { p0 = __builtin_amdgcn_mfma_f32_32x32x16_bf16(b0, qr[0], cinit, 0, 0, 0); p1 = __builtin_amdgcn_mfma_f32_32x32x16_bf16(b1, qr[0], cinit, 0, 0, 0); }
        else { p0 = __builtin_amdgcn_mfma_f32_32x32x16_bf16(b0, qr[d0], p0, 0, 0, 0); p1 = __builtin_amdgcn_mfma_f32_32x32x16_bf16(b1, qr[d0], p1, 0, 0, 0); }
    }
}
template <int NDB> __device__ __forceinline__ void softmax_step(f32x16& p0, f32x16& p1, float& mhat, float& l, f32x16* o, LAS float* wsf, int r32, int hi, float bc) {
    float a = fmaxf(p0[0], p1[0]);
#pragma unroll
    for (int r = 1; r < 16; ++r) a = fmaxf(a, fmaxf(p0[r], p1[r]));
    const float rm = hmax32(a) + bc;
    if (__any(rm > mhat + THR)) {
        const float mn = fmaxf(mhat, rm), f = __builtin_amdgcn_exp2f(mhat - mn);
        l *= f; mhat = mn;
        if (hi == 0) wsf[r32] = f;
        float fr[16]; const LAS float* wq = wsf + 4 * hi;
#pragma unroll
        for (int r = 0; r < 16; ++r) fr[r] = wq[crow0(r)];
#pragma unroll
        for (int d = 0; d < NDB; ++d)
#pragma unroll
            for (int r = 0; r < 16; ++r) o[d][r] *= fr[r];
    }
    float s = 0.f; const float mref = mhat - bc;
#pragma unroll
    for (int r = 0; r < 16; ++r) { p0[r] = __builtin_amdgcn_exp2f(p0[r] - mref); p1[r] = __builtin_amdgcn_exp2f(p1[r] - mref); s += p0[r] + p1[r]; }
    l += s;
}
__device__ __forceinline__ void packp(u32x4* pw, const f32x16& p0, const f32x16& p1) {
    pw[0] = (u32x4){cvtpk(p0[0], p0[1]), cvtpk(p0[2], p0[3]), cvtpk(p0[4], p0[5]), cvtpk(p0[6], p0[7])};
    pw[1] = (u32x4){cvtpk(p0[8], p0[9]), cvtpk(p0[10], p0[11]), cvtpk(p0[12], p0[13]), cvtpk(p0[14], p0[15])};
    pw[2] = (u32x4){cvtpk(p1[0], p1[1]), cvtpk(p1[2], p1[3]), cvtpk(p1[4], p1[5]), cvtpk(p1[6], p1[7])};
    pw[3] = (u32x4){cvtpk(p1[8], p1[9]), cvtpk(p1[10], p1[11]), cvtpk(p1[12], p1[13]), cvtpk(p1[14], p1[15])};
}
__device__ __forceinline__ bf16x8 vfrag(ldscp vp, int db, int ks) {
    const s16x4 lo = vtr(vp + db * 4096 + ks * 1024), hi = vtr(vp + db * 4096 + ks * 1024 + 512);
    return (bf16x8){lo[0], lo[1], lo[2], lo[3], hi[0], hi[1], hi[2], hi[3]};
}
__device__ __forceinline__ int vlane_off(int lane) { const int hi = lane >> 5; return ((lane >> 4) & 1) * 32 + (lane & 3) * 8 + (4 * hi + ((lane & 15) >> 2)) * 64; }

struct Ctx {
    const bf16_t* Z; bf16_t* AO;
    const float *cak, *cav, *cbk, *cbv;
    const float *subln_g, *onb;
    float lam;
    LAS unsigned char* lds;
    int tid, lane, wid, r32, hi;
};

struct DiffState { float m, l; f32x16 o[4]; bf16x8 q[4]; };

template <bool NEAR> __device__ __forceinline__ void diff_tile(DiffState& S, const Ctx& c, ldscp slot, float bfar, int h, int relb, bool half) {
    LAS float* wsf = (LAS float*)(c.lds + L_WSF) + c.wid * 64;
    const LAS float* t5 = (const LAS float*)(c.lds + L_T5) + h * 512;
    const f32x16 zero = f32x16{};
    f32x16 p0, p1; u32x4 pw[4];
    qkt(p0, p1, slot + (c.wid >> 2) * 8192, S.q, zero, c.r32, c.hi);
    if (NEAR) {
        const LAS float* tb = t5 + (relb + 4 * c.hi);
#pragma unroll
        for (int r = 0; r < 16; ++r) { p0[r] += tb[crow0(r)]; p1[r] += tb[crow0(r) + 32]; }
    }
    if (half) {
#pragma unroll
        for (int r = 0; r < 16; ++r) p1[r] = NEGBIG;
    }
    softmax_step<4>(p0, p1, S.m, S.l, S.o, wsf, c.r32, c.hi, NEAR ? 0.f : bfar);
    packp(pw, p0, p1);
    ldscp vp = slot + 16384 + vlane_off(c.lane);
    __builtin_amdgcn_sched_barrier(0);
#pragma unroll
    for (int db = 0; db < 4; ++db) {
#pragma unroll
        for (int ks = 0; ks < 4; ++ks) {
            const bf16x8 vf = vfrag(vp, db, ks);
            S.o[db] = __builtin_amdgcn_mfma_f32_32x32x16_bf16(__builtin_bit_cast(bf16x8, pw[ks]), vf, S.o[db], 0, 0, 0);
        }
        __builtin_amdgcn_sched_barrier(0);
    }
}
__device__ __forceinline__ void diff_init(DiffState& S, const Ctx& c, const bf16_t* qrow  ) {
    S.m = NEGBIG; S.l = 0.f;
#pragma unroll
    for (int d = 0; d < 4; ++d) S.o[d] = f32x16{};
#pragma unroll
    for (int d0 = 0; d0 < 4; ++d0) S.q[d0] = *(const bf16x8*)(qrow + d0 * 16 + c.hi * 8);
}
__device__ __forceinline__ void diff_finish(DiffState& S, const Ctx& c, int h, size_t orow0, bool active) {
    LAS float* wsf = (LAS float*)(c.lds + L_WSF) + c.wid * 64;
    LAS float* xo = (LAS float*)c.lds + (c.wid & 3) * 4096;
    const float lt = S.l + __shfl_xor(S.l, 32);
    if (c.wid >= 4) {
        if (c.hi == 0) wsf[c.r32] = c.lam / lt;
        float sc[16]; const LAS float* wq = wsf + 4 * c.hi;
#pragma unroll
        for (int r = 0; r < 16; ++r) sc[r] = wq[crow0(r)];
        if (active) {
#pragma unroll
            for (int db = 0; db < 4; ++db)
#pragma unroll
                for (int r = 0; r < 16; ++r) xo[(db * 16 + r) * 64 + c.lane] = S.o[db][r] * sc[r];
        }
    }
    __syncthreads();
    if (c.wid < 4 && active) {
        if (c.hi == 0) wsf[c.r32] = 1.0f / lt;
        float g[4];
#pragma unroll
        for (int db = 0; db < 4; ++db) g[db] = c.subln_g[db * 32 + c.r32] * 0.8f;
        const LAS float* wq = wsf + 4 * c.hi;
        bf16_t* ob = c.AO + (orow0 + 4 * c.hi) * DM + h * 128 + c.r32;
#pragma unroll
        for (int r = 0; r < 16; ++r) {
            const float a = wq[crow0(r)];
            float v[4], ss = 0.f;
#pragma unroll
            for (int db = 0; db < 4; ++db) { v[db] = S.o[db][r] * a - xo[(db * 16 + r) * 64 + c.lane]; ss += v[db] * v[db]; }
            ss += __shfl_xor(ss, 1); ss += __shfl_xor(ss, 2); ss += __shfl_xor(ss, 4); ss += __shfl_xor(ss, 8); ss += __shfl_xor(ss, 16);
            const float rs = 1.0f / sqrtf(ss * (1.0f / 128.0f) + 1e-5f);
            bf16_t* op = ob + crow0(r) * DM;
#pragma unroll
            for (int db = 0; db < 4; ++db) op[db * 32] = (bf16_t)(cvtpk(v[db] * rs * g[db], 0.f) & 0xffffu);
        }
    }
    __syncthreads();
}
__device__ __forceinline__ void diff_prompt_unit(const Ctx& c0, int b, int h, int qb) {
    Ctx c = c0; c.lane = pg8::lane_late(); c.tid = c.wid * 64 + c.lane; c.r32 = c.lane & 31; c.hi = c.lane >> 5;
    const int q0 = qb * 128, NT = qb * 2 + 2, wq = c.wid & 3, tlast = qb * 2 + (wq >> 1);
    const size_t rowb = (size_t)b * SEQ;
    const size_t qrow = rowb + q0 + wq * 32 + c.r32;
    DiffState S; diff_init(S, c, c.Z + qrow * NZ + h * 128 + (c.wid >> 2) * 64);
    const float cfar = ((const LAS float*)(c.lds + L_T5))[h * 512 + 448 - 100];
    const bf16_t* k1src = c.Z + (rowb + c.lane) * NZ + 512 + h * 128 + c.wid * 8;
    const bf16_t* vsrc0 = c.Z + (rowb + 16 * (c.wid & 3) + (c.lane >> 2)) * NZ + 1024 + h * 128 + (c.wid >> 2) * 32 + (c.lane & 3) * 8;
    const int wofs = c.wid * 1024 + c.lane * 16;
    u32x4 r0, r1, r2, r3;
#define DP_LOAD(t) do { const size_t o_ = (size_t)(t) * 64 * NZ; r0 = *(const u32x4*)(k1src + o_); r1 = *(const u32x4*)(k1src + o_ + 64); r2 = *(const u32x4*)(vsrc0 + o_); r3 = *(const u32x4*)(vsrc0 + o_ + 64); } while (0)
#define DP_WRITE(buf) do { ldsp s_ = c.lds + (buf) * 32768; *(LAS u32x4*)(s_ + wofs) = r0; *(LAS u32x4*)(s_ + 8192 + wofs) = r1; *(LAS u32x4*)(s_ + 16384 + wofs) = r2; *(LAS u32x4*)(s_ + 16384 + 8192 + wofs) = r3; } while (0)
    DP_LOAD(0); DP_WRITE(0); __syncthreads();
    for (int t = 0; t < NT; ++t) {
        if (t + 1 < NT) DP_LOAD(t + 1);
        if (t <= tlast) {
            ldscp slot = c.lds + (t & 1) * 32768;
            if (t >= qb * 2 - 2) diff_tile<true>(S, c, slot, cfar, h, 64 * t - (q0 + wq * 32 + c.r32) + 448, false);
            else diff_tile<false>(S, c, slot, cfar, h, 0, false);
        }
        if (t + 1 < NT) DP_WRITE((t + 1) & 1);
        __syncthreads();
    }
#undef DP_LOAD
#undef DP_WRITE
    diff_finish(S, c, h, rowb + q0 + wq * 32, true);
}
__device__ __forceinline__ void diff_sample_unit(const Ctx& c0, int b, int h) {
    Ctx c = c0; c.lane = pg8::lane_late(); c.tid = c.wid * 64 + c.lane; c.r32 = c.lane & 31; c.hi = c.lane >> 5;
    const size_t qrow = (size_t)MP + b * SS + c.r32;
    DiffState S; diff_init(S, c, c.Z + qrow * NZ + h * 128 + (c.wid >> 2) * 64);
    const float cfar = ((const LAS float*)(c.lds + L_T5))[h * 512 + 448 - 100];
    const int wofs = c.wid * 1024 + c.lane * 16;
    const bool active = (c.wid & 3) == 0;
    for (int t = 0; t <= 16; ++t) {
        u32x4 r0, r1, r2, r3;
        if (t < 16) {
            const float* ks = c.cak + (((size_t)(b * PAST + 64 * t + c.lane) * 4 + h) * 2) * 64 + c.wid * 8;
            r0 = cvt8(*(const f32x4*)ks, *(const f32x4*)(ks + 4)); r1 = cvt8(*(const f32x4*)(ks + 64), *(const f32x4*)(ks + 68));
            __builtin_amdgcn_sched_barrier(0);
            const float* vs = c.cav + ((size_t)(b * PAST + 64 * t + 16 * (c.wid & 3) + (c.lane >> 2)) * 4 + h) * 128 + (c.wid >> 2) * 32 + (c.lane & 3) * 8;
            r2 = cvt8(*(const f32x4*)vs, *(const f32x4*)(vs + 4)); r3 = cvt8(*(const f32x4*)(vs + 64), *(const f32x4*)(vs + 68));
        } else {
            const u32x4 z4 = (u32x4){0u, 0u, 0u, 0u};
            r0 = z4; r1 = z4; r2 = z4; r3 = z4;
            if (c.lane < 32) { const bf16_t* ks = c.Z + ((size_t)MP + b * SS + c.lane) * NZ + 512 + h * 128 + c.wid * 8; r0 = *(const u32x4*)ks; r1 = *(const u32x4*)(ks + 64); }
            const int vk = 16 * (c.wid & 3) + (c.lane >> 2);
            if (vk < 32) { const bf16_t* vs = c.Z + ((size_t)MP + b * SS + vk) * NZ + 1024 + h * 128 + (c.wid >> 2) * 32 + (c.lane & 3) * 8; r2 = *(const u32x4*)vs; r3 = *(const u32x4*)(vs + 64); }
        }
        ldsp s_ = c.lds;
        *(LAS u32x4*)(s_ + wofs) = r0; *(LAS u32x4*)(s_ + 8192 + wofs) = r1; *(LAS u32x4*)(s_ + 16384 + wofs) = r2; *(LAS u32x4*)(s_ + 16384 + 8192 + wofs) = r3;
        __builtin_amdgcn_sched_barrier(0);
        __syncthreads();
        if (active) {
            const int relb = 64 * t - (PAST + c.r32) + 448;
            if (t >= 14) diff_tile<true>(S, c, c.lds, cfar, h, relb, t == 16);
            else diff_tile<false>(S, c, c.lds, cfar, h, 0, false);
        }
        __syncthreads();
    }
    diff_finish(S, c, h, (size_t)MP + b * SS, active);
}

template <int NQ> __device__ __forceinline__ void band_unit(const Ctx& c0, int b, int ch) {
    Ctx c = c0; c.lane = pg8::lane_late(); c.tid = c.wid * 64 + c.lane; c.r32 = c.lane & 31; c.hi = c.lane >> 5;
    const int h = c.wid;
    constexpr bool SAMPLE = (NQ == 1);
    const size_t qrow0 = SAMPLE ? (size_t)MP + b * SS : (size_t)b * SEQ + ch * 64;
    LAS float* wsf = (LAS float*)(c.lds + L_WSF) + c.wid * 64;
    const LAS float* bt = (const LAS float*)(c.lds + L_BT) + h * 264;
    ldsp ks = c.lds + c.wid * 16384; ldsp vs = ks + 8192;
    bf16x8 qr[NQ][4]; float mh[NQ], l[NQ]; f32x16 o[NQ][2];
#pragma unroll
    for (int q = 0; q < NQ; ++q) {
        mh[q] = NEGBIG; l[q] = 0.f; o[q][0] = f32x16{}; o[q][1] = f32x16{};
        const bf16_t* qp = c.Z + (qrow0 + q * 32 + c.r32) * NZ + 1536 + h * 64;
#pragma unroll
        for (int d0 = 0; d0 < 4; ++d0) qr[q][d0] = *(const bf16x8*)(qp + d0 * 16 + c.hi * 8);
    }
    const int jt0 = SAMPLE ? 0 : (ch >= 8 ? 0 : 8 - ch);
    const f32x16 zero = f32x16{};
    for (int jt = jt0; jt <= 8; ++jt) {
        bool half = false;
        if (!SAMPLE || jt == 8) {
            const size_t krow0 = SAMPLE ? (size_t)MP + b * SS : (size_t)b * SEQ + (size_t)(ch - 8 + jt) * 64;
            if (SAMPLE) half = true;
#pragma unroll 2
            for (int p = 0; p < 8; ++p) {
                u32x4 kv = (u32x4){0u, 0u, 0u, 0u}, vv = kv;
                if (!SAMPLE || c.lane < 32) kv = *(const u32x4*)(c.Z + (krow0 + c.lane) * NZ + 2048 + h * 64 + p * 8);
                const int vk = 16 * (p & 3) + (c.lane >> 2);
                if (!SAMPLE || vk < 32) vv = *(const u32x4*)(c.Z + (krow0 + vk) * NZ + 2560 + h * 64 + (p >> 2) * 32 + (c.lane & 3) * 8);
                *(LAS u32x4*)(ks + p * 1024 + c.lane * 16) = kv; *(LAS u32x4*)(vs + p * 1024 + c.lane * 16) = vv;
            }
        } else {
#pragma unroll 1
            for (int p = 0; p < 8; ++p) {
                const float* kp = c.cbk + ((size_t)(b * CBL + jt * 64 + c.lane) * 8 + h) * 64 + p * 8;
                const float* vp = c.cbv + ((size_t)(b * CBL + jt * 64 + 16 * (p & 3) + (c.lane >> 2)) * 8 + h) * 64 + (p >> 2) * 32 + (c.lane & 3) * 8;
                *(LAS u32x4*)(ks + p * 1024 + c.lane * 16) = cvt8(*(const f32x4*)kp, *(const f32x4*)(kp + 4));
                *(LAS u32x4*)(vs + p * 1024 + c.lane * 16) = cvt8(*(const f32x4*)vp, *(const f32x4*)(vp + 4));
            }
        }
        __builtin_amdgcn_sched_barrier(0);
        u32x4 pw[NQ][4];
#pragma unroll
        for (int q = 0; q < NQ; ++q) {
            f32x16 p0, p1;
            qkt(p0, p1, ks, qr[q], zero, c.r32, c.hi);
            const int relb = SAMPLE ? (jt == 8 ? -c.r32 : 64 * jt - 512 - c.r32) : (jt - 8) * 64 - (q * 32 + c.r32);
            const int relh = relb + 4 * c.hi;
#pragma unroll
            for (int r = 0; r < 16; ++r) {
                int i0 = relh + crow0(r), i1 = relh + crow0(r) + 32;
                i0 = (i0 < -128 ? -128 : (i0 > 128 ? 128 : i0)) + 128; i1 = (i1 < -128 ? -128 : (i1 > 128 ? 128 : i1)) + 128;
                p0[r] += bt[i0]; p1[r] += bt[i1];
            }
            if (half) {
#pragma unroll
                for (int r = 0; r < 16; ++r) p1[r] = NEGBIG;
            }
            softmax_step<2>(p0, p1, mh[q], l[q], o[q], wsf, c.r32, c.hi, 0.f);
            packp(pw[q], p0, p1);
        }
        ldscp vp = vs + vlane_off(c.lane);
        __builtin_amdgcn_sched_barrier(0);
#pragma unroll
        for (int db = 0; db < 2; ++db) {
#pragma unroll
            for (int ksx = 0; ksx < 4; ++ksx) {
                const bf16x8 vf = vfrag(vp, db, ksx);
#pragma unroll
                for (int q = 0; q < NQ; ++q) o[q][db] = __builtin_amdgcn_mfma_f32_32x32x16_bf16(__builtin_bit_cast(bf16x8, pw[q][ksx]), vf, o[q][db], 0, 0, 0);
            }
            __builtin_amdgcn_sched_barrier(0);
        }
    }
    LAS float* xch = (LAS float*)(c.lds + L_XCH);
    float rl[NQ][16];
#pragma unroll
    for (int q = 0; q < NQ; ++q) {
        const float lt = l[q] + __shfl_xor(l[q], 32);
        if (c.hi == 0) wsf[c.r32] = 1.0f / lt;
#pragma unroll
        for (int r = 0; r < 16; ++r) rl[q][r] = (wsf + 4 * c.hi)[crow0(r)];
#pragma unroll
        for (int r = 0; r < 16; ++r) {
            o[q][0][r] *= rl[q][r]; o[q][1][r] *= rl[q][r];
            float ss = o[q][0][r] * o[q][0][r] + o[q][1][r] * o[q][1][r];
            ss += __shfl_xor(ss, 1); ss += __shfl_xor(ss, 2); ss += __shfl_xor(ss, 4); ss += __shfl_xor(ss, 8); ss += __shfl_xor(ss, 16);
            if (c.r32 == 0) (xch + (q * 32 + 4 * c.hi) * 8 + h)[crow0(r) * 8] = ss;
        }
    }
    __syncthreads();
    const float g0 = c.onb[h * 64 + c.r32], g1 = c.onb[h * 64 + 32 + c.r32];
#pragma unroll
    for (int q = 0; q < NQ; ++q)
#pragma unroll
        for (int r = 0; r < 16; ++r) {
            const LAS float* xr = xch + (q * 32 + 4 * c.hi) * 8 + crow0(r) * 8;
            const f32x4 a = *(const LAS f32x4*)(xr), bq = *(const LAS f32x4*)(xr + 4);
            const float tot = ((a[0] + a[1]) + (a[2] + a[3])) + ((bq[0] + bq[1]) + (bq[2] + bq[3]));
            const float rs = 1.0f / sqrtf(tot * (1.0f / 512.0f) + 1e-6f);
            bf16_t* op = c.AO + (qrow0 + q * 32 + 4 * c.hi) * DM + 512 + h * 64 + c.r32 + crow0(r) * DM;
            op[0] = (bf16_t)(cvtpk(o[q][0][r] * rs * g0, 0.f) & 0xffffu);
            op[32] = (bf16_t)(cvtpk(o[q][1][r] * rs * g1, 0.f) & 0xffffu);
        }
    __syncthreads();
}
#undef LAS
}

#define LAS __attribute__((address_space(3)))
typedef unsigned short bf16;
typedef float f32x4 __attribute__((ext_vector_type(4)));
typedef unsigned v4u __attribute__((ext_vector_type(4)));
constexpr int NWAVES = 8, NTHREADS = NWAVES * 64;
constexpr int LDS_BYTES = 155648;
constexpr int L_MISC = att::L_END;
static_assert(L_MISC + 64 <= LDS_BYTES, "LDS map");
#ifndef MK_MULTI
#define MK_MULTI 0
#endif
constexpr int N_PHASES = 8;
constexpr size_t MiB = 1u << 20;
constexpr size_t WS_WIN = 0, WS_WOUT = 6 * MiB, WS_WUP = 8 * MiB, WS_WDN = 16 * MiB, WS_WG = 24 * MiB, WS_WP = 26 * MiB;
constexpr size_t WS_CTL = 26 * MiB + 512 * 1024, CTL_BYTES = 16384;
constexpr size_t WS_SS1 = 27 * MiB, WS_SS2 = 30 * MiB;
constexpr size_t WS_PB = 33 * MiB;
constexpr size_t WS_B = 50 * MiB;
constexpr size_t WS_C = 116 * MiB;
constexpr size_t WS_A = 182 * MiB;
constexpr size_t WS_END = WS_A + (size_t)MT * DFF * 2;
static_assert(WS_END <= 512 * MiB && WS_PB + (size_t)MT * DPLE * 2 <= WS_B && WS_B + (size_t)MT * DM * 2 <= WS_C && WS_C + (size_t)MT * DM * 2 <= WS_A && WS_SS2 + (size_t)MT * 64 <= WS_PB, "d_ws map");

#define XB_TMO      128
#define XB_XCNT(j)  (256  + 64 * (j))
#define XB_XSUB(j)  (1280 + 64 * (j))
#define XB_XGEN(j)  (2304 + 64 * (j))
#define XB_TOP      3328
#define XB_TOPGEN   3392
#define XCD_BAR_WORDS 3456
#define XB_SPIN_CAP (1u << 24)
__device__ __forceinline__ unsigned xb_ld(unsigned* p)              { return __hip_atomic_load(p, __ATOMIC_RELAXED, __HIP_MEMORY_SCOPE_AGENT); }
__device__ __forceinline__ unsigned xb_add(unsigned* p, unsigned v) { return __hip_atomic_fetch_add(p, v, __ATOMIC_RELAXED, __HIP_MEMORY_SCOPE_AGENT); }
__device__ __forceinline__ unsigned xb_xcc_id() { return (unsigned)__builtin_amdgcn_s_getreg((3 << 11) | 20) & 0xFu; }
#define XB_SPIN(cond, bar) do { unsigned _sp = 0; while (cond) { __builtin_amdgcn_s_sleep(1); \
    if ((++_sp & 255u) == 0u) { if (xb_ld(&(bar)[XB_TMO])) break; if (_sp > XB_SPIN_CAP) { atomicAdd(&(bar)[XB_TMO], 1u); break; } } } } while (0)
struct XcdBarrier { unsigned* bar; unsigned x; volatile LAS unsigned* st; };
__device__ __forceinline__ void xcd_barrier_complete(unsigned* bar, unsigned x, unsigned& nloc, unsigned& nx) {
    const unsigned G = gridDim.x;
    unsigned sum, cnt, mine, sp = 0u;
    for (;;) {
        sum = 0u; cnt = 0u; mine = 0u;
#pragma unroll
        for (unsigned j = 0; j < 16; ++j) { const unsigned c = xb_ld(&bar[XB_XCNT(j)]); sum += c; cnt += (c > 0u) ? 1u : 0u; mine = (j == x) ? c : mine; }
        if (sum == G) break;
        __builtin_amdgcn_s_sleep(1);
        if ((++sp & 255u) == 0u) { if (xb_ld(&bar[XB_TMO])) break; if (sp > XB_SPIN_CAP) { atomicAdd(&bar[XB_TMO], 1u); break; } }
    }
    nloc = mine > 0u ? mine : 1u; nx = cnt > 0u ? cnt : 1u;
}
__device__ __forceinline__ void xcd_barrier(const XcdBarrier& b, bool leader) {
    asm volatile("s_waitcnt vmcnt(0)" ::: "memory");
    __syncthreads();
    if (leader) {
        unsigned* bar = b.bar;
        __builtin_amdgcn_s_waitcnt(0);
        unsigned nloc = b.st[0], nx = b.st[1];
        if (nloc == 0u) { xcd_barrier_complete(bar, b.x, nloc, nx); b.st[0] = nloc; b.st[1] = nx; }
        const unsigned old = xb_add(&bar[XB_XSUB(b.x)], 1u);
        const unsigned gen = old / nloc;
        if (old + 1u == (gen + 1u) * nloc) {
            __builtin_amdgcn_fence(__ATOMIC_RELEASE, "agent");
            asm volatile("s_waitcnt vmcnt(0)" ::: "memory");
            const unsigned og = xb_add(&bar[XB_TOP], 1u);
            const unsigned tg = og / nx;
            if (og + 1u == (tg + 1u) * nx) xb_add(&bar[XB_TOPGEN], 1u);
            else XB_SPIN(xb_ld(&bar[XB_TOPGEN]) == tg, bar);
            __builtin_amdgcn_fence(__ATOMIC_ACQUIRE, "agent");
            xb_add(&bar[XB_XGEN(b.x)], 1u);
            asm volatile("s_waitcnt vmcnt(0)" ::: "memory");
        } else {
            XB_SPIN(xb_ld(&bar[XB_XGEN(b.x)]) == gen, bar);
            __builtin_amdgcn_fence(__ATOMIC_ACQUIRE, "agent");
            asm volatile("s_waitcnt vmcnt(0)" ::: "memory");
        }
    }
    __syncthreads();
}

struct Args {
    const float *xp, *xs, *cak, *cav, *cbk, *cbv, *pp, *ps, *t5, *g_attn, *w_in, *lq1, *lk1, *lq2, *lk2, *subln, *bandt, *onb, *w_out, *g_mlp, *w_up, *w_down, *w_gate, *w_proj, *g_final;
    float* out; unsigned char* ws; int ph_lo, ph_hi;
};

__device__ __forceinline__ float wave_sum(float v) {
#pragma unroll
    for (int o = 1; o < 64; o <<= 1) v += __shfl_xor(v, o);
    return v;
}
__device__ __forceinline__ void p0_transpose_item(const float* W, int K, int N, bf16* WT, const float* kscale, LAS float* scr, int item, int lane) {
    const int nblk = N / 32, kb = item / nblk, nb = item % nblk, k0 = 64 * kb, n0 = 32 * nb;
#pragma unroll 8
    for (int i = 0; i < 32; ++i) { const int kk = 2 * i + (lane >> 5); float v = W[(size_t)(k0 + kk) * N + n0 + (lane & 31)]; if (kscale) v *= kscale[k0 + kk]; scr[kk * 33 + (lane & 31)] = v; }
    asm volatile("s_waitcnt lgkmcnt(0)" ::: "memory");
    const int c = lane & 7;
#pragma unroll
    for (int j = 0; j < 4; ++j) { const int n = (lane >> 3) + 8 * j; const LAS float* s = scr + (8 * c) * 33 + n;
        v4u o; o.x = pg8::cvt_pk_bf16(s[0 * 33], s[1 * 33]); o.y = pg8::cvt_pk_bf16(s[2 * 33], s[3 * 33]); o.z = pg8::cvt_pk_bf16(s[4 * 33], s[5 * 33]); o.w = pg8::cvt_pk_bf16(s[6 * 33], s[7 * 33]);
        *(v4u*)(WT + (size_t)(n0 + n) * K + k0 + 8 * c) = o; }
    asm volatile("s_waitcnt lgkmcnt(0)" ::: "memory");
}

__global__ void __launch_bounds__(NTHREADS, 2) mk_fwd(Args a) {
    extern __shared__ __attribute__((aligned(16))) unsigned char lds_raw[];
    LAS unsigned char* lds = (LAS unsigned char*)lds_raw;
    const int G = gridDim.x, bid = blockIdx.x;
    const int wave = __builtin_amdgcn_readfirstlane(threadIdx.x >> 6);
    XcdBarrier xbar; xbar.bar = (unsigned*)(a.ws + WS_CTL); xbar.x = xb_xcc_id(); xbar.st = (volatile LAS unsigned*)(lds + L_MISC);
#if !MK_MULTI
    { const int l0 = pg8::lane_late();
      if (wave == 0 && l0 < 2) xbar.st[l0] = 0u;
      if (wave == 0 && l0 == 0) (void)xb_add(&xbar.bar[XB_XCNT(xbar.x)], 1u);
      __syncthreads(); }
#endif
#define TID_HERE() const int lane = pg8::lane_late(), tid = wave * 64 + lane; (void)tid
    unsigned char* ws = a.ws;
    bf16 *Win_t = (bf16*)(ws + WS_WIN), *Wout_t = (bf16*)(ws + WS_WOUT), *Wup_t = (bf16*)(ws + WS_WUP), *Wdn_t = (bf16*)(ws + WS_WDN), *Wg_t = (bf16*)(ws + WS_WG), *Wp_t = (bf16*)(ws + WS_WP);
    float *SS1 = (float*)(ws + WS_SS1), *SS2 = (float*)(ws + WS_SS2);
    bf16 *PB = (bf16*)(ws + WS_PB), *XN = (bf16*)(ws + WS_B), *AO = (bf16*)(ws + WS_B), *PP = (bf16*)(ws + WS_B), *HB = (bf16*)(ws + WS_C), *Z = (bf16*)(ws + WS_A), *U = (bf16*)(ws + WS_A);
    float* Y = a.out + O_Y;
    const int lo = a.ph_lo, hi = a.ph_hi;
#ifndef PH_MASK
#define PH_MASK 0xff
#endif
#define IN(k) (((PH_MASK >> (k)) & 1) && lo <= (k) && (k) < hi)
#if MK_MULTI
#define GRID_BAR() do {} while (0)
#else
#define GRID_BAR() do { const bool ldr_ = (wave == 0) && (pg8::lane_late() == 0); xcd_barrier(xbar, ldr_); } while (0)
#endif

    if (IN(0)) {
        TID_HERE();
        LAS float* scr = (LAS float*)(lds + wave * 16384);
        const int gw = bid * NWAVES + wave, NGW = G * NWAVES;
        constexpr int I_IN = (DM / 64) * (NZ / 32), I_OUT = (DM / 64) * (DM / 32), I_UP = (DM / 64) * (DFF / 32), I_DN = (DFF / 64) * (DM / 32), I_G = I_OUT, I_P = (DPLE / 64) * (DM / 32);
        constexpr int NITEMS = I_IN + I_OUT + I_UP + I_DN + I_G + I_P;
        for (int it = gw; it < NITEMS; it += NGW) {
            int r = it;
            if (r < I_IN) { p0_transpose_item(a.w_in, DM, NZ, Win_t, nullptr, scr, r, lane); continue; } r -= I_IN;
            if (r < I_OUT) { p0_transpose_item(a.w_out, DM, DM, Wout_t, nullptr, scr, r, lane); continue; } r -= I_OUT;
            if (r < I_UP) { p0_transpose_item(a.w_up, DM, DFF, Wup_t, a.g_mlp, scr, r, lane); continue; } r -= I_UP;
            if (r < I_DN) { p0_transpose_item(a.w_down, DFF, DM, Wdn_t, nullptr, scr, r, lane); continue; } r -= I_DN;
            if (r < I_G) { p0_transpose_item(a.w_gate, DM, DM, Wg_t, nullptr, scr, r, lane); continue; } r -= I_G;
            p0_transpose_item(a.w_proj, DPLE, DM, Wp_t, nullptr, scr, r, lane);
        }
        for (int m = gw; m < MT; m += NGW) {
            const float* xr = m < MP ? a.xp + (size_t)m * DM : a.xs + (size_t)(m - MP) * DM;
            f32x4 v[4], g[4]; float s = 0.f;
#pragma unroll
            for (int j = 0; j < 4; ++j) { v[j] = ((const f32x4*)xr)[lane + 64 * j]; g[j] = ((const f32x4*)a.g_attn)[lane + 64 * j]; s += (v[j][0] * v[j][0] + v[j][1] * v[j][1]) + (v[j][2] * v[j][2] + v[j][3] * v[j][3]); }
            const float rstd = 1.0f / sqrtf(wave_sum(s) * (1.0f / DM) + 1e-6f);
            unsigned long long* o8 = (unsigned long long*)(XN + (size_t)m * DM);
#pragma unroll
            for (int j = 0; j < 4; ++j) o8[lane + 64 * j] = (unsigned long long)pg8::cvt_pk_bf16(v[j][0] * rstd * g[j][0], v[j][1] * rstd * g[j][1]) | ((unsigned long long)pg8::cvt_pk_bf16(v[j][2] * rstd * g[j][2], v[j][3] * rstd * g[j][3]) << 32);
            const float* pr = m < MP ? a.pp + (size_t)m * DPLE : a.ps + (size_t)(m - MP) * DPLE;
            const f32x4 pv = ((const f32x4*)pr)[lane];
            ((unsigned long long*)(PB + (size_t)m * DPLE))[lane] = (unsigned long long)pg8::cvt_pk_bf16(pv[0], pv[1]) | ((unsigned long long)pg8::cvt_pk_bf16(pv[2], pv[3]) << 32);
        }
        if (IN(1)) GRID_BAR();
    }
    if (IN(1)) {
        pg8::Gemm g{XN, Win_t, MT, NZ, DM}; pg8::StaticOrder S; S.init(MT, NZ, G, bid);
        pg8::EpiQKV E{Z, a.out};
        pg8::gemm_phase<pg8::EpiQKV, pg8::StaticOrder, true, true>(lds, g, S, E, wave);
        if (IN(2)) GRID_BAR();
    }
    if (IN(2)) {
        TID_HERE();
        att::Ctx c; c.Z = Z; c.AO = AO; c.cak = a.cak; c.cav = a.cav; c.cbk = a.cbk; c.cbv = a.cbv; c.subln_g = a.subln; c.onb = a.onb;
        c.lds = lds; c.tid = tid; c.lane = lane; c.wid = wave; c.r32 = lane & 31; c.hi = lane >> 5;
        { float d1 = 0.f, d2 = 0.f;
          for (int i = 0; i < 64; ++i) { d1 += a.lq1[i] * a.lk1[i]; d2 += a.lq2[i] * a.lk2[i]; }
          c.lam = expf(d1) - expf(d2) + 0.2f; }
        for (int i = tid; i < 4 * 512; i += NTHREADS) { const int h = i >> 9, rel = (i & 511) - 448; ((LAS float*)(lds + att::L_T5))[i] = LOG2E * a.t5[att::t5_bucket(rel) * 4 + h]; }
        for (int i = tid; i < 8 * 264; i += NTHREADS) { const int h = i / 264, j = i % 264; ((LAS float*)(lds + att::L_BT))[i] = j <= 256 ? LOG2E * a.bandt[j * 8 + h] : 0.f; }
        __syncthreads();
#ifndef P2_MASK
#define P2_MASK 15
#endif
        if (P2_MASK & 1) for (int u = bid; u < 1024; u += G) {
            const int v = u & 255, bh = v & 7, s = v >> 3, rnd = u >> 8, qb = rnd == 0 ? s : rnd == 1 ? 127 - s : rnd == 2 ? 63 - s : 64 + s;
            att::diff_prompt_unit(c, bh >> 2, bh & 3, qb);
        }
        if (P2_MASK & 2) for (int u = bid; u < 512; u += G) att::band_unit<2>(c, u >> 8, u & 255);
        if (P2_MASK & 4) for (int u = bid; u < 64; u += G) att::diff_sample_unit(c, u >> 2, u & 3);
        if (P2_MASK & 8) for (int u = bid; u < 16; u += G) att::band_unit<1>(c, u, 0);
        if (IN(3)) GRID_BAR();
    }
    if (IN(3)) {
        pg8::Gemm g{AO, Wout_t, MT, DM, DM}; pg8::StaticOrder S; S.init(MT, DM, G, bid);
        pg8::EpiOut E{a.xp, a.xs, Y, HB, SS1};
        pg8::gemm_phase<pg8::EpiOut, pg8::StaticOrder, true, true>(lds, g, S, E, wave);
        if (IN(4)) GRID_BAR();
    }
    if (IN(4)) {
        { pg8::Gemm g{HB, Wup_t, MT, DFF, DM}; pg8::StaticOrder S; S.init(MT, DFF, G, bid);
          pg8::EpiUp E{U, SS1};
          pg8::gemm_phase<pg8::EpiUp, pg8::StaticOrder, true, true>(lds, g, S, E, wave); }
        { int kp = DPLE; asm volatile("" : "+s"(kp));
          pg8::Gemm g{PB, Wp_t, MT, DM, kp}; pg8::StaticOrder S; S.init(MT, DM, G, bid);
          pg8::EpiPP E{PP};
          pg8::gemm_phase<pg8::EpiPP, pg8::StaticOrder, true, true>(lds, g, S, E, wave); }
        if (IN(5)) GRID_BAR();
    }
    if (IN(5)) {
        pg8::Gemm g{U, Wdn_t, MT, DM, DFF}; pg8::StaticOrder S; S.init(MT, DM, G, bid);
        pg8::EpiDown E{Y, HB};
        pg8::gemm_phase<pg8::EpiDown, pg8::StaticOrder, true, true>(lds, g, S, E, wave);
        if (IN(6)) GRID_BAR();
    }
    if (IN(6)) {
        pg8::Gemm g{HB, Wg_t, MT, DM, DM}; pg8::StaticOrder S; S.init(MT, DM, G, bid);
        pg8::EpiGate E{Y, PP, SS2};
        pg8::gemm_phase<pg8::EpiGate, pg8::StaticOrder, true, true>(lds, g, S, E, wave);
        if (IN(7)) GRID_BAR();
    }
    if (IN(7)) {
        TID_HERE();
        const int gw = bid * NWAVES + wave, NGW = G * NWAVES;
        for (int m = gw; m < MT; m += NGW) {
            float* yr = Y + (size_t)m * DM;
            const float sv = lane < 16 ? SS2[(size_t)m * 16 + lane] : 0.f;
            const float rstd = 1.0f / sqrtf(wave_sum(sv) * (1.0f / DM) + 1e-6f);
#pragma unroll
            for (int j = 0; j < 4; ++j) { const f32x4 v = ((const f32x4*)yr)[lane + 64 * j], g = ((const f32x4*)a.g_final)[lane + 64 * j]; ((f32x4*)yr)[lane + 64 * j] = v * rstd * g; }
        }
    }
#undef IN
#undef GRID_BAR
}

extern "C" void kernel_launch(void* const* d_in, const int* in_sizes, int n_in, void* d_out, int out_size, void* d_ws, size_t ws_size, hipStream_t stream) {
    static int grid = 0;
    if (grid == 0) {
        if (n_in != 25 || (size_t)out_size != O_END || ws_size < WS_END) { fprintf(stderr, "kernel_launch: unexpected sizes n_in %d out %d ws %zu\n", n_in, out_size, ws_size); grid = -1; return; }
        int dev = 0, cus = 0, per_cu = 0;
        if (hipGetDevice(&dev) != hipSuccess || hipDeviceGetAttribute(&cus, hipDeviceAttributeMultiprocessorCount, dev) != hipSuccess) { grid = -1; return; }
        if (hipFuncSetAttribute((const void*)mk_fwd, hipFuncAttributeMaxDynamicSharedMemorySize, LDS_BYTES) != hipSuccess) { fprintf(stderr, "kernel_launch: hipFuncSetAttribute failed\n"); grid = -1; return; }
        if (hipOccupancyMaxActiveBlocksPerMultiprocessor(&per_cu, (const void*)mk_fwd, NTHREADS, LDS_BYTES) != hipSuccess || per_cu < 1) { fprintf(stderr, "kernel_launch: occupancy query says %d\n", per_cu); (void)hipGetLastError(); per_cu = 1; }
        grid = cus;
    }
    if (grid < 0) return;
    Args a{};
    const float** f = (const float**)&a.xp;
    for (int i = 0; i < 25; ++i) f[i] = (const float*)d_in[i];
    a.out = (float*)d_out; a.ws = (unsigned char*)d_ws;
#if MK_MULTI
    for (int p = 0; p < N_PHASES; ++p) { a.ph_lo = p; a.ph_hi = p + 1; hipLaunchKernelGGL(mk_fwd, dim3(grid), dim3(NTHREADS), LDS_BYTES, stream, a); }
#else
    a.ph_lo = 0; a.ph_hi = N_PHASES;
    if (hipMemsetAsync((char*)d_ws + WS_CTL, 0, CTL_BYTES, stream) != hipSuccess) { fprintf(stderr, "kernel_launch: memset failed\n"); return; }
    hipLaunchKernelGGL(mk_fwd, dim3(grid), dim3(NTHREADS), LDS_BYTES, stream, a);
#endif
}
```

```cpp
#include <hip/hip_runtime.h>
#include <hip/hip_cooperative_groups.h>
#include <hip/hip_bf16.h>
#include <cstdio>
#include <cstdint>
namespace cg = cooperative_groups;

constexpr int DM = 1024, SEQ = 16384, NB = 2, MP = NB * SEQ  , SB = 16, SS = 32, MS = SB * SS  , MT = MP + MS  ;
constexpr int PAST = 1024, CBL = 512, NZ = 3072, DFF = 4096, DPLE = 256;
constexpr float LOG2E = 1.4426950408889634f, C2 = 0.125f * LOG2E;
constexpr size_t O_Y = 0, O_AKP = (size_t)MT * DM, O_AVP = O_AKP + (size_t)MP * 512, O_BKP = O_AVP + (size_t)MP * 512, O_BVP = O_BKP + (size_t)NB * 512 * 512,
                 O_AKS = O_BVP + (size_t)NB * 512 * 512, O_AVS = O_AKS + (size_t)MS * 512, O_BKS = O_AVS + (size_t)MS * 512, O_BVS = O_BKS + (size_t)MS * 512, O_END = O_BVS + (size_t)MS * 512;

namespace pg8 {
#define PG8_LAS __attribute__((address_space(3)))
typedef unsigned short bf16_t;
typedef short bf16x8 __attribute__((ext_vector_type(8)));
typedef float f32x4 __attribute__((ext_vector_type(4)));
typedef unsigned u32x4 __attribute__((ext_vector_type(4)));
constexpr int BM = 256, BK = 64, HALF = 128, HTB = HALF * BK * 2  , STAGE_BYTES = 8 * HTB, NXCD = 8, WGM = 8;

__host__ __device__ __forceinline__ int lds_byte(int r, int c) { const int st = (r >> 4) * 2 + (c >> 5), rr = r & 15, cc = c & 31, ob = rr * 64 + cc * 2; return st * 1024 + (ob ^ (((ob >> 9) & 1) << 5)); }
__host__ __device__ __forceinline__ void stage_rc(int b, int& R, int& C) { const int st = b / 1024, sb = b % 1024, swz = sb ^ (((sb >> 9) & 1) << 5); R = (st >> 1) * 16 + swz / 64; C = (st & 1) * 32 + (swz % 64) / 2; }
__host__ __device__ __forceinline__ int perm32(int rho) { const int n = rho >> 4, i = rho & 15; return 8 * (i >> 2) + 4 * n + (i & 3); }

struct Unit { int pm, pn; };
struct Gemm { const bf16_t* A; const bf16_t* Bt; int M, N, K; };

struct StaticOrder {
    int nM, nN, nwg, G, c;
    __host__ __device__ void init(int M, int N, int G_, int c_) { nM = M / BM; nN = N / BM; nwg = nM * nN; G = G_; c = c_; }
    __host__ __device__ bool next(int i, Unit& u) const {
        const long L = (long)i * G + c; if (L >= nwg) return false;
        int wgid = (int)L; { const int q = nwg / NXCD, r = nwg % NXCD, xcd = wgid % NXCD, off = wgid / NXCD; wgid = (xcd < r ? xcd * (q + 1) : r * (q + 1) + (xcd - r) * q) + off; }
        const int nig = WGM * nN, gid = wgid / nig, fm = gid * WGM, gsz = (nM - fm) < WGM ? (nM - fm) : WGM;
        u.pm = fm + ((wgid % nig) % gsz); u.pn = (wgid % nig) / gsz; return true;
    }
    __device__ __forceinline__ void a_ready(const Unit&) const {}
    __device__ __forceinline__ void done(const Unit&) const {}
};


typedef float f32x2 __attribute__((ext_vector_type(2)));
typedef __bf16 bf16x2_t __attribute__((ext_vector_type(2)));
__device__ __forceinline__ unsigned cvt_pk_bf16(float lo, float hi) { f32x2 v = {lo, hi}; bf16x2_t b = __builtin_convertvector(v, bf16x2_t); return __builtin_bit_cast(unsigned, b); }
__device__ __forceinline__ int lane_late() { int ln; asm volatile("v_mbcnt_lo_u32_b32 %0, -1, 0\n\tv_mbcnt_hi_u32_b32 %0, -1, %0" : "=v"(ln)); return ln; }
__device__ __forceinline__ u32x4 pack8(const f32x4& a, const f32x4& b) { u32x4 w; w.x = cvt_pk_bf16(a[0], a[1]); w.y = cvt_pk_bf16(a[2], a[3]); w.z = cvt_pk_bf16(b[0], b[1]); w.w = cvt_pk_bf16(b[2], b[3]); return w; }

struct EpiQKV {
    static constexpr bool PERM = true, AFTER_DRAIN = false;
    bf16_t* Z; float* out;
    __device__ __forceinline__ void operator()(const f32x4 (&acc)[2][2][4][2], const Unit& u, int wr, int wc, int fr, int fq) const {
        { const int ln_ = lane_late(); fr = ln_ & 15; fq = ln_ >> 4; }
        const int seg = u.pn >> 1;
        const float sc = (seg == 0 || seg == 3) ? C2 : 1.0f;
        const int row0 = u.pm * BM + wr * 64 + fr, col0 = u.pn * BM + wc * 32 + 8 * fq, cs0 = col0 - seg * 512;
#pragma unroll
        for (int ai = 0; ai < 2; ++ai)
#pragma unroll
            for (int m = 0; m < 4; ++m) {
                const int row = row0 + ai * HALF + m * 16;
                bf16_t* zp = Z + (size_t)row * NZ + col0;
                float* fp = nullptr;
                if (seg == 1 || seg == 2 || seg == 4 || seg == 5) {
                    if (row < MP) {
                        if (seg == 1) fp = out + O_AKP + (size_t)row * 512;
                        else if (seg == 2) fp = out + O_AVP + (size_t)row * 512;
                        else { const int t = row & (SEQ - 1), b = row >> 14; if (t >= SEQ - 512) fp = out + (seg == 4 ? O_BKP : O_BVP) + (size_t)(b * 512 + t - (SEQ - 512)) * 512; }
                    } else {
                        const int rs = row - MP;
                        fp = out + (seg == 1 ? O_AKS : seg == 2 ? O_AVS : seg == 4 ? O_BKS : O_BVS) + (size_t)rs * 512;
                    }
                }
#pragma unroll
                for (int bj = 0; bj < 2; ++bj) {
                    const f32x4 v0 = acc[ai][bj][m][0], v1 = acc[ai][bj][m][1];
                    *(u32x4*)(zp + bj * HALF) = pack8(v0 * sc, v1 * sc);
                    if (fp) { *(f32x4*)(fp + cs0 + bj * HALF) = v0; *(f32x4*)(fp + cs0 + bj * HALF + 4) = v1; }
                }
            }
    }
};
struct EpiOut {
    static constexpr bool PERM = true, AFTER_DRAIN = false;
    const float* xp; const float* xs; float* Y; bf16_t* HB; float* SSQ;
    __device__ __forceinline__ void operator()(const f32x4 (&acc)[2][2][4][2], const Unit& u, int wr, int wc, int fr, int fq) const {
        { const int ln_ = lane_late(); fr = ln_ & 15; fq = ln_ >> 4; }
        const int row0 = u.pm * BM + wr * 64 + fr, col0 = u.pn * BM + wc * 32 + 8 * fq;
#pragma unroll
        for (int ai = 0; ai < 2; ++ai)
#pragma unroll
            for (int m = 0; m < 4; ++m) {
                const int row = row0 + ai * HALF + m * 16;
                const float* xr = (row < MP ? xp + (size_t)row * DM : xs + (size_t)(row - MP) * DM) + col0;
                float ss = 0.f;
#pragma unroll
                for (int bj = 0; bj < 2; ++bj) {
                    const f32x4 h0 = *(const f32x4*)(xr + bj * HALF) + acc[ai][bj][m][0], h1 = *(const f32x4*)(xr + bj * HALF + 4) + acc[ai][bj][m][1];
                    float* yp = Y + (size_t)row * DM + col0 + bj * HALF; *(f32x4*)yp = h0; *(f32x4*)(yp + 4) = h1;
                    *(u32x4*)(HB + (size_t)row * DM + col0 + bj * HALF) = pack8(h0, h1);
                    ss += (h0[0] * h0[0] + h0[1] * h0[1]) + (h0[2] * h0[2] + h0[3] * h0[3]) + (h1[0] * h1[0] + h1[1] * h1[1]) + (h1[2] * h1[2] + h1[3] * h1[3]);
                }
                ss += __shfl_xor(ss, 16); ss += __shfl_xor(ss, 32);
                if (fq == 0) SSQ[(size_t)row * 16 + u.pn * 4 + wc] = ss;
            }
    }
};
struct EpiUp {
    static constexpr bool PERM = true, AFTER_DRAIN = false;
    bf16_t* U; const float* SSQ;
    __device__ __forceinline__ void operator()(const f32x4 (&acc)[2][2][4][2], const Unit& u, int wr, int wc, int fr, int fq) const {
        { const int ln_ = lane_late(); fr = ln_ & 15; fq = ln_ >> 4; }
        const int row0 = u.pm * BM + wr * 64 + fr, col0 = u.pn * BM + wc * 32 + 8 * fq;
#pragma unroll
        for (int ai = 0; ai < 2; ++ai)
#pragma unroll
            for (int m = 0; m < 4; ++m) {
                const int row = row0 + ai * HALF + m * 16;
                const f32x4 s0 = ((const f32x4*)(SSQ + (size_t)row * 16))[fq];
                float tot = (s0[0] + s0[1]) + (s0[2] + s0[3]);
                tot += __shfl_xor(tot, 16); tot += __shfl_xor(tot, 32);
                const float rstd = 1.0f / sqrtf(tot * (1.0f / DM) + 1e-6f);
#pragma unroll
                for (int bj = 0; bj < 2; ++bj) {
                    f32x4 v0 = acc[ai][bj][m][0] * rstd, v1 = acc[ai][bj][m][1] * rstd;
#pragma unroll
                    for (int j = 0; j < 4; ++j) { const float a = fmaxf(v0[j], 0.f), b = fmaxf(v1[j], 0.f); v0[j] = a * a; v1[j] = b * b; }
                    *(u32x4*)(U + (size_t)row * DFF + col0 + bj * HALF) = pack8(v0, v1);
                }
            }
    }
};
struct EpiPP {
    static constexpr bool PERM = true, AFTER_DRAIN = false;
    bf16_t* PP;
    __device__ __forceinline__ void operator()(const f32x4 (&acc)[2][2][4][2], const Unit& u, int wr, int wc, int fr, int fq) const {
        { const int ln_ = lane_late(); fr = ln_ & 15; fq = ln_ >> 4; }
        const int row0 = u.pm * BM + wr * 64 + fr, col0 = u.pn * BM + wc * 32 + 8 * fq;
#pragma unroll
        for (int ai = 0; ai < 2; ++ai)
#pragma unroll
            for (int m = 0; m < 4; ++m) {
                const int row = row0 + ai * HALF + m * 16;
#pragma unroll
                for (int bj = 0; bj < 2; ++bj) *(u32x4*)(PP + (size_t)row * DM + col0 + bj * HALF) = pack8(acc[ai][bj][m][0], acc[ai][bj][m][1]);
            }
    }
};
struct EpiDown {
    static constexpr bool PERM = true, AFTER_DRAIN = false;
    float* Y; bf16_t* HB;
    __device__ __forceinline__ void operator()(const f32x4 (&acc)[2][2][4][2], const Unit& u, int wr, int wc, int fr, int fq) const {
        { const int ln_ = lane_late(); fr = ln_ & 15; fq = ln_ >> 4; }
        const int row0 = u.pm * BM + wr * 64 + fr, col0 = u.pn * BM + wc * 32 + 8 * fq;
#pragma unroll
        for (int ai = 0; ai < 2; ++ai)
#pragma unroll
            for (int m = 0; m < 4; ++m) {
                const int row = row0 + ai * HALF + m * 16;
#pragma unroll
                for (int bj = 0; bj < 2; ++bj) {
                    float* yp = Y + (size_t)row * DM + col0 + bj * HALF;
                    const f32x4 h0 = *(const f32x4*)yp + acc[ai][bj][m][0], h1 = *(const f32x4*)(yp + 4) + acc[ai][bj][m][1];
                    *(f32x4*)yp = h0; *(f32x4*)(yp + 4) = h1;
                    *(u32x4*)(HB + (size_t)row * DM + col0 + bj * HALF) = pack8(h0, h1);
                }
            }
    }
};
struct EpiGate {
    static constexpr bool PERM = true, AFTER_DRAIN = false;
    float* Y; const bf16_t* PP; float* SSQ;
    __device__ __forceinline__ void operator()(const f32x4 (&acc)[2][2][4][2], const Unit& u, int wr, int wc, int fr, int fq) const {
        { const int ln_ = lane_late(); fr = ln_ & 15; fq = ln_ >> 4; }
        const int row0 = u.pm * BM + wr * 64 + fr, col0 = u.pn * BM + wc * 32 + 8 * fq;
#pragma unroll
        for (int ai = 0; ai < 2; ++ai)
#pragma unroll
            for (int m = 0; m < 4; ++m) {
                const int row = row0 + ai * HALF + m * 16;
                float ss = 0.f;
#pragma unroll
                for (int bj = 0; bj < 2; ++bj) {
                    float* yp = Y + (size_t)row * DM + col0 + bj * HALF;
                    const u32x4 pw = *(const u32x4*)(PP + (size_t)row * DM + col0 + bj * HALF);
                    f32x4 p0, p1;
                    p0[0] = __uint_as_float(pw.x << 16); p0[1] = __uint_as_float(pw.x & 0xffff0000u); p0[2] = __uint_as_float(pw.y << 16); p0[3] = __uint_as_float(pw.y & 0xffff0000u);
                    p1[0] = __uint_as_float(pw.z << 16); p1[1] = __uint_as_float(pw.z & 0xffff0000u); p1[2] = __uint_as_float(pw.w << 16); p1[3] = __uint_as_float(pw.w & 0xffff0000u);
                    f32x4 h0 = *(const f32x4*)yp, h1 = *(const f32x4*)(yp + 4);
                    const f32x4 a0 = acc[ai][bj][m][0], a1 = acc[ai][bj][m][1];
#pragma unroll
                    for (int j = 0; j < 4; ++j) {
                        const float g0 = __builtin_amdgcn_rcpf(1.0f + __builtin_amdgcn_exp2f(-LOG2E * a0[j])), g1 = __builtin_amdgcn_rcpf(1.0f + __builtin_amdgcn_exp2f(-LOG2E * a1[j]));
                        h0[j] += g0 * p0[j]; h1[j] += g1 * p1[j];
                    }
                    *(f32x4*)yp = h0; *(f32x4*)(yp + 4) = h1;
                    ss += (h0[0] * h0[0] + h0[1] * h0[1]) + (h0[2] * h0[2] + h0[3] * h0[3]) + (h1[0] * h1[0] + h1[1] * h1[1]) + (h1[2] * h1[2] + h1[3] * h1[3]);
                }
                ss += __shfl_xor(ss, 16); ss += __shfl_xor(ss, 32);
                if (fq == 0) SSQ[(size_t)row * 16 + u.pn * 4 + wc] = ss;
            }
    }
};

template <class Epi, class Sched, bool ALIGN_EPI = false, bool SP2 = false>
__device__ __forceinline__ void gemm_phase(PG8_LAS unsigned char* lds, const Gemm g, const Sched& S, const Epi& E, const int wave_s  ) {
    const int wid = wave_s, lane = lane_late(), tid = wid * 64 + lane, wr = wid >> 2, wc = wid & 3, fr = lane & 15, fq = lane >> 4;
    const int K = g.K, nt = K / BK;
    unsigned voffA[2], voffB[2];
#pragma unroll
    for (int i = 0; i < 2; ++i) { int R, C; stage_rc(tid * 16 + i * 8192, R, C); const int Rb = Epi::PERM ? ((R & ~31) + perm32(R & 31)) : R;
        voffA[i] = (unsigned)(R * K + C) * 2u; voffB[i] = (unsigned)(Rb * K + C) * 2u; }
    const size_t kstep = (size_t)(BK * 2);
    const size_t hstep = (size_t)HALF * K * 2;
    const size_t tstep = 2 * hstep;
    const unsigned ldsw = (unsigned)wid * 1024u;
    const int aoff = lds_byte(wr * 64 + fr, fq * 8), boff = lds_byte(wc * 32 + fr, fq * 8);
#define PG8_SA(b, h) (((b) * 2 + (h)) * HTB)
#define PG8_SB(b, h) ((4 + (b) * 2 + (h)) * HTB)
#define PG8_STAGE(bufoff, gbase, voff) do { _Pragma("unroll") for (int _i = 0; _i < 2; ++_i) \
        __builtin_amdgcn_global_load_lds((const unsigned*)((const char*)(gbase) + (voff)[_i]), (PG8_LAS unsigned*)(lds + (bufoff) + ldsw + _i * 8192), 16, 0, 0); } while (0)
#define PG8_LDA(dst, b, h) do { _Pragma("unroll") for (int m = 0; m < 4; ++m) _Pragma("unroll") for (int k = 0; k < 2; ++k) dst[m][k] = *(const PG8_LAS bf16x8*)(lds + PG8_SA(b, h) + aoff + m * 2048 + k * 1024); } while (0)
#define PG8_LDB(dst, b, h) do { _Pragma("unroll") for (int n = 0; n < 2; ++n) _Pragma("unroll") for (int k = 0; k < 2; ++k) dst[n][k] = *(const PG8_LAS bf16x8*)(lds + PG8_SB(b, h) + boff + n * 2048 + k * 1024); } while (0)
#define PG8_MMA(ai, bj, At, Bt) do { __builtin_amdgcn_s_setprio(1); _Pragma("unroll") for (int m = 0; m < 4; ++m) _Pragma("unroll") for (int n = 0; n < 2; ++n) _Pragma("unroll") for (int k = 0; k < 2; ++k) \
        acc[ai][bj][m][n] = __builtin_amdgcn_mfma_f32_16x16x32_bf16(Bt[n][k], At[m][k], acc[ai][bj][m][n], 0, 0, 0); __builtin_amdgcn_s_setprio(0); } while (0)
#define PG8_WAIT_V(n) asm volatile("s_waitcnt vmcnt(" #n ")" ::: "memory")
#define PG8_WAIT_L(n) asm volatile("s_waitcnt lgkmcnt(" #n ")" ::: "memory")
#define PG8_BAR __builtin_amdgcn_s_barrier()
#define PG8_SCHED __builtin_amdgcn_sched_barrier(0)
    Unit cur, nxt; int ui = 0;
    if (!S.next(0, cur)) return;
    f32x4 acc[2][2][4][2];
#pragma unroll
    for (int a = 0; a < 2; ++a)
#pragma unroll
        for (int b = 0; b < 2; ++b)
#pragma unroll
            for (int m = 0; m < 4; ++m)
#pragma unroll
                for (int n = 0; n < 2; ++n) acc[a][b][m][n] = (f32x4){0.f, 0.f, 0.f, 0.f};
    bf16x8 At[4][2], B0[2][2], B1[2][2];
    const char* cA = (const char*)g.A + (size_t)cur.pm * tstep; const char* cB = (const char*)g.Bt + (size_t)cur.pn * tstep;
    S.a_ready(cur);
    if constexpr (SP2) {
        PG8_STAGE(PG8_SB(0, 0), cB, voffB); PG8_STAGE(PG8_SB(0, 1), cB + hstep, voffB); PG8_STAGE(PG8_SA(0, 0), cA, voffA); PG8_STAGE(PG8_SA(0, 1), cA + hstep, voffA);
        if (wr == 1) PG8_BAR;
        PG8_WAIT_V(2); PG8_BAR;
        PG8_STAGE(PG8_SB(1, 0), cB + kstep, voffB); PG8_STAGE(PG8_SA(1, 0), cA + kstep, voffA); PG8_STAGE(PG8_SB(1, 1), cB + hstep + kstep, voffB);
        PG8_WAIT_V(6); PG8_BAR;
    } else {
        PG8_STAGE(PG8_SB(0, 0), cB, voffB); PG8_STAGE(PG8_SA(0, 0), cA, voffA); PG8_STAGE(PG8_SB(0, 1), cB + hstep, voffB); PG8_STAGE(PG8_SA(0, 1), cA + hstep, voffA);
        if (wr == 1) PG8_BAR;
        PG8_WAIT_V(4); PG8_BAR;
        PG8_STAGE(PG8_SB(1, 0), cB + kstep, voffB); PG8_STAGE(PG8_SA(1, 0), cA + kstep, voffA); PG8_STAGE(PG8_SB(1, 1), cB + hstep + kstep, voffB);
        PG8_WAIT_V(6); PG8_BAR;
    }
    for (;;) {
        const bool has_next = S.next(ui + 1, nxt);
        const char* nA = has_next ? (const char*)g.A + (size_t)nxt.pm * tstep : cA; const char* nB = has_next ? (const char*)g.Bt + (size_t)nxt.pn * tstep : cB;
        for (int t = 0; t < nt; t += 2) {
            const bool last = (t == nt - 2);
            const char* a1 = cA + (size_t)(t + 1) * kstep;
            const char* a2 = last ? nA : cA + (size_t)(t + 2) * kstep; const char* b2 = last ? nB : cB + (size_t)(t + 2) * kstep;
            const char* a3 = a2 + kstep; const char* b3 = b2 + kstep;
            if (last && has_next) S.a_ready(nxt);
            if constexpr (SP2) {
            PG8_LDB(B0, 0, 0); PG8_LDB(B1, 0, 1); PG8_SCHED; PG8_LDA(At, 0, 0); PG8_STAGE(PG8_SA(1, 1), a1 + hstep, voffA);
            PG8_WAIT_V(8); PG8_WAIT_L(0); PG8_BAR; PG8_MMA(0, 0, At, B0); PG8_MMA(0, 1, At, B1); PG8_BAR; PG8_SCHED;
            PG8_LDA(At, 0, 1); PG8_STAGE(PG8_SB(0, 0), b2, voffB); PG8_STAGE(PG8_SB(0, 1), b2 + hstep, voffB); PG8_STAGE(PG8_SA(0, 0), a2, voffA);
            PG8_WAIT_V(8); PG8_WAIT_L(0); PG8_BAR; PG8_MMA(1, 0, At, B0); PG8_MMA(1, 1, At, B1); PG8_BAR; PG8_SCHED;
            PG8_LDB(B0, 1, 0); PG8_LDB(B1, 1, 1); PG8_SCHED; PG8_LDA(At, 1, 0); PG8_STAGE(PG8_SA(0, 1), a2 + hstep, voffA);
            PG8_WAIT_V(8); PG8_WAIT_L(0); PG8_BAR; PG8_MMA(0, 0, At, B0); PG8_MMA(0, 1, At, B1); PG8_BAR; PG8_SCHED;
            PG8_LDA(At, 1, 1); PG8_STAGE(PG8_SB(1, 0), b3, voffB); PG8_STAGE(PG8_SB(1, 1), b3 + hstep, voffB); PG8_STAGE(PG8_SA(1, 0), a3, voffA);
            PG8_WAIT_V(8); PG8_WAIT_L(0); PG8_BAR; PG8_MMA(1, 0, At, B0); PG8_MMA(1, 1, At, B1); PG8_BAR; PG8_SCHED;
            } else {
            PG8_LDB(B0, 0, 0); PG8_SCHED; PG8_LDA(At, 0, 0); PG8_STAGE(PG8_SA(1, 1), a1 + hstep, voffA);
            PG8_WAIT_L(8); PG8_BAR; PG8_WAIT_L(0); PG8_MMA(0, 0, At, B0); PG8_BAR; PG8_SCHED;
            PG8_LDB(B1, 0, 1); PG8_STAGE(PG8_SB(0, 0), b2, voffB);
            PG8_BAR; PG8_WAIT_L(0); PG8_MMA(0, 1, At, B1); PG8_BAR;
            PG8_LDA(At, 0, 1); PG8_STAGE(PG8_SA(0, 0), a2, voffA);
            PG8_BAR; PG8_WAIT_L(0); PG8_MMA(1, 0, At, B0); PG8_BAR; PG8_SCHED;
            PG8_STAGE(PG8_SB(0, 1), b2 + hstep, voffB);
            PG8_WAIT_V(6); PG8_BAR; PG8_MMA(1, 1, At, B1); PG8_BAR;
            PG8_LDB(B0, 1, 0); PG8_SCHED; PG8_LDA(At, 1, 0); PG8_STAGE(PG8_SA(0, 1), a2 + hstep, voffA);
            PG8_WAIT_L(8); PG8_BAR; PG8_WAIT_L(0); PG8_MMA(0, 0, At, B0); PG8_BAR; PG8_SCHED;
            PG8_LDB(B1, 1, 1); PG8_STAGE(PG8_SB(1, 0), b3, voffB);
            PG8_BAR; PG8_WAIT_L(0); PG8_MMA(0, 1, At, B1); PG8_BAR;
            PG8_LDA(At, 1, 1); PG8_STAGE(PG8_SA(1, 0), a3, voffA);
            PG8_BAR; PG8_WAIT_L(0); PG8_MMA(1, 0, At, B0); PG8_BAR; PG8_SCHED;
            PG8_STAGE(PG8_SB(1, 1), b3 + hstep, voffB);
            PG8_WAIT_V(6); PG8_BAR; PG8_MMA(1, 1, At, B1); PG8_BAR;
            }
        }
        if constexpr (ALIGN_EPI) { if (wr == 0) PG8_BAR; }
        if constexpr (!Epi::AFTER_DRAIN) { E(acc, cur, wr, wc, fr, fq); S.done(cur); }
        if (!has_next) break;
#pragma unroll
        for (int a = 0; a < 2; ++a)
#pragma unroll
            for (int b = 0; b < 2; ++b)
#pragma unroll
                for (int m = 0; m < 4; ++m)
#pragma unroll
                    for (int n = 0; n < 2; ++n) acc[a][b][m][n] = (f32x4){0.f, 0.f, 0.f, 0.f};
        cur = nxt; cA = nA; cB = nB; ++ui;
        if constexpr (ALIGN_EPI) { if (wr == 1) PG8_BAR; }
    }
    PG8_WAIT_V(0);
    if constexpr (!ALIGN_EPI) { if (wr == 0) PG8_BAR; }
    PG8_BAR;
    if constexpr (Epi::AFTER_DRAIN) { E.fused(acc, cur, wr, wc, fr, fq, lds, wid, lane); S.done(cur); }
#undef PG8_SA
#undef PG8_SB
#undef PG8_STAGE
#undef PG8_LDA
#undef PG8_LDB
#undef PG8_MMA
#undef PG8_WAIT_V
#undef PG8_WAIT_L
#undef PG8_BAR
#undef PG8_SCHED
}
}

namespace att {
#define LAS __attribute__((address_space(3)))
typedef unsigned short bf16_t;
typedef short bf16x8 __attribute__((ext_vector_type(8)));
typedef short s16x4 __attribute__((ext_vector_type(4)));
typedef short v4i16_t __attribute__((ext_vector_type(4)));
typedef float f32x16 __attribute__((ext_vector_type(16)));
typedef float f32x4 __attribute__((ext_vector_type(4)));
typedef unsigned u32x4 __attribute__((ext_vector_type(4)));
typedef LAS unsigned char* ldsp;
typedef const LAS unsigned char* ldscp;
constexpr float THR = 8.0f;
constexpr float NEGBIG = -1.0e30f;
constexpr int L_T5 = 131072;
constexpr int L_BT = L_T5 + 8192;
constexpr int L_WSF = L_BT + 8448;
constexpr int L_XCH = L_WSF + 2048;
constexpr int L_END = L_XCH + 2048;

__device__ __forceinline__ int crow(int r, int hi) { return (r & 3) + 8 * (r >> 2) + 4 * hi; }
__device__ __forceinline__ constexpr int crow0(int r) { return (r & 3) + 8 * (r >> 2); }
__device__ __forceinline__ unsigned cvtpk(float lo, float hi) { return pg8::cvt_pk_bf16(lo, hi); }
__device__ __forceinline__ s16x4 vtr(ldscp p) { return __builtin_bit_cast(s16x4, __builtin_amdgcn_ds_read_tr16_b64_v4i16((LAS v4i16_t*)p)); }
__device__ __forceinline__ float hmax32(float m) { return fmaxf(m, __shfl_xor(m, 32)); }
__device__ __forceinline__ u32x4 cvt8(const f32x4& a, const f32x4& b) { return pg8::pack8(a, b); }
__device__ __forceinline__ int t5_bucket(int rel) {
    int n = -rel; const int ret = n < 0 ? 16 : 0; n = n < 0 ? -n : n;
    if (n < 8) return ret + n;
    return ret + 8 + (n >= 12) + (n >= 16) + (n >= 23) + (n >= 32) + (n >= 46) + (n >= 64) + (n >= 91);
}

__device__ __forceinline__ void qkt(f32x16& p0, f32x16& p1, ldscp Kslot, const bf16x8* qr, const f32x16& cinit, int r32, int hi) {
    ldscp kb = Kslot + hi * 1024 + r32 * 16;
#pragma unroll
    for (int d0 = 0; d0 < 4; ++d0) {
        const bf16x8 b0 = *(const LAS bf16x8*)(kb + d0 * 2048);
        const bf16x8 b1 = *(const LAS bf16x8*)(kb + d0 * 2048 + 512);
        if (d0 == 0) { p0 = __builtin_amdgcn_mfma_f32_32x32x16_bf16(b0, qr[0], cinit, 0, 0, 0); p1 = __builtin_amdgcn_mfma_f32_32x32x16_bf16(b1, qr[0], cinit, 0, 0, 0); }
        else { p0 = __builtin_amdgcn_mfma_f32_32x32x16_bf16(b0, qr[d0], p0, 0, 0, 0); p1 = __builtin_amdgcn_mfma_f32_32x32x16_bf16(b1, qr[d0], p1, 0, 0, 0); }
    }
}
template <int NDB> __device__ __forceinline__ void softmax_step(f32x16& p0, f32x16& p1, float& mhat, float& l, f32x16* o, LAS float* wsf, int r32, int hi, float bc) {
    float a = fmaxf(p0[0], p1[0]);
#pragma unroll
    for (int r = 1; r < 16; ++r) a = fmaxf(a, fmaxf(p0[r], p1[r]));
    const float rm = hmax32(a) + bc;
    if (__any(rm > mhat + THR)) {
        const float mn = fmaxf(mhat, rm), f = __builtin_amdgcn_exp2f(mhat - mn);
        l *= f; mhat = mn;
        if (hi == 0) wsf[r32] = f;
        float fr[16]; const LAS float* wq = wsf + 4 * hi;
#pragma unroll
        for (int r = 0; r < 16; ++r) fr[r] = wq[crow0(r)];
#pragma unroll
        for (int d = 0; d < NDB; ++d)
#pragma unroll
            for (int r = 0; r < 16; ++r) o[d][r] *= fr[r];
    }
    float s = 0.f; const float mref = mhat - bc;
#pragma unroll
    for (int r = 0; r < 16; ++r) { p0[r] = __builtin_amdgcn_exp2f(p0[r] - mref); p1[r] = __builtin_amdgcn_exp2f(p1[r] - mref); s += p0[r] + p1[r]; }
    l += s;
}
__device__ __forceinline__ void packp(u32x4* pw, const f32x16& p0, const f32x16& p1) {
    pw[0] = (u32x4){cvtpk(p0[0], p0[1]), cvtpk(p0[2], p0[3]), cvtpk(p0[4], p0[5]), cvtpk(p0[6], p0[7])};
    pw[1] = (u32x4){cvtpk(p0[8], p0[9]), cvtpk(p0[10], p0[11]), cvtpk(p0[12], p0[13]), cvtpk(p0[14], p0[15])};
    pw[2] = (u32x4){cvtpk(p1[0], p1[1]), cvtpk(p1[2], p1[3]), cvtpk(p1[4], p1[5]), cvtpk(p1[6], p1[7])};
    pw[3] = (u32x4){cvtpk(p1[8], p1[9]), cvtpk(p1[10], p1[11]), cvtpk(p1[12], p1[13]), cvtpk(p1[14], p1[15])};
}
__device__ __forceinline__ bf16x8 vfrag(ldscp vp, int db, int ks) {
    const s16x4 lo = vtr(vp + db * 4096 + ks * 1024), hi = vtr(vp + db * 4096 + ks * 1024 + 512);
    return (bf16x8){lo[0], lo[1], lo[2], lo[3], hi[0], hi[1], hi[2], hi[3]};
}
__device__ __forceinline__ int vlane_off(int lane) { const int hi = lane >> 5; return ((lane >> 4) & 1) * 32 + (lane & 3) * 8 + (4 * hi + ((lane & 15) >> 2)) * 64; }

struct Ctx {
    const bf16_t* Z; bf16_t* AO;
    const float *cak, *cav, *cbk, *cbv;
    const float *subln_g, *onb;
    float lam;
    LAS unsigned char* lds;
    int tid, lane, wid, r32, hi;
};

struct DiffState { float m, l; f32x16 o[4]; bf16x8 q[4]; };

template <bool NEAR> __device__ __forceinline__ void diff_tile(DiffState& S, const Ctx& c, ldscp slot, float bfar, int h, int relb, bool half) {
    LAS float* wsf = (LAS float*)(c.lds + L_WSF) + c.wid * 64;
    const LAS float* t5 = (const LAS float*)(c.lds + L_T5) + h * 512;
    const f32x16 zero = f32x16{};
    f32x16 p0, p1; u32x4 pw[4];
    qkt(p0, p1, slot + (c.wid >> 2) * 8192, S.q, zero, c.r32, c.hi);
    if (NEAR) {
        const LAS float* tb = t5 + (relb + 4 * c.hi);
#pragma unroll
        for (int r = 0; r < 16; ++r) { p0[r] += tb[crow0(r)]; p1[r] += tb[crow0(r) + 32]; }
    }
    if (half) {
#pragma unroll
        for (int r = 0; r < 16; ++r) p1[r] = NEGBIG;
    }
    softmax_step<4>(p0, p1, S.m, S.l, S.o, wsf, c.r32, c.hi, NEAR ? 0.f : bfar);
    packp(pw, p0, p1);
    ldscp vp = slot + 16384 + vlane_off(c.lane);
    __builtin_amdgcn_sched_barrier(0);
#pragma unroll
    for (int db = 0; db < 4; ++db) {
#pragma unroll
        for (int ks = 0; ks < 4; ++ks) {
            const bf16x8 vf = vfrag(vp, db, ks);
            S.o[db] = __builtin_amdgcn_mfma_f32_32x32x16_bf16(__builtin_bit_cast(bf16x8, pw[ks]), vf, S.o[db], 0, 0, 0);
        }
        __builtin_amdgcn_sched_barrier(0);
    }
}
__device__ __forceinline__ void diff_init(DiffState& S, const Ctx& c, const bf16_t* qrow  ) {
    S.m = NEGBIG; S.l = 0.f;
#pragma unroll
    for (int d = 0; d < 4; ++d) S.o[d] = f32x16{};
#pragma unroll
    for (int d0 = 0; d0 < 4; ++d0) S.q[d0] = *(const bf16x8*)(qrow + d0 * 16 + c.hi * 8);
}
__device__ __forceinline__ void diff_finish(DiffState& S, const Ctx& c, int h, size_t orow0, bool active) {
    LAS float* wsf = (LAS float*)(c.lds + L_WSF) + c.wid * 64;
    LAS float* xo = (LAS float*)c.lds + (c.wid & 3) * 4096;
    const float lt = S.l + __shfl_xor(S.l, 32);
    if (c.wid >= 4) {
        if (c.hi == 0) wsf[c.r32] = c.lam / lt;
        float sc[16]; const LAS float* wq = wsf + 4 * c.hi;
#pragma unroll
        for (int r = 0; r < 16; ++r) sc[r] = wq[crow0(r)];
        if (active) {
#pragma unroll
            for (int db = 0; db < 4; ++db)
#pragma unroll
                for (int r = 0; r < 16; ++r) xo[(db * 16 + r) * 64 + c.lane] = S.o[db][r] * sc[r];
        }
    }
    __syncthreads();
    if (c.wid < 4 && active) {
        if (c.hi == 0) wsf[c.r32] = 1.0f / lt;
        float g[4];
#pragma unroll
        for (int db = 0; db < 4; ++db) g[db] = c.subln_g[db * 32 + c.r32] * 0.8f;
        const LAS float* wq = wsf + 4 * c.hi;
        bf16_t* ob = c.AO + (orow0 + 4 * c.hi) * DM + h * 128 + c.r32;
#pragma unroll
        for (int r = 0; r < 16; ++r) {
            const float a = wq[crow0(r)];
            float v[4], ss = 0.f;
#pragma unroll
            for (int db = 0; db < 4; ++db) { v[db] = S.o[db][r] * a - xo[(db * 16 + r) * 64 + c.lane]; ss += v[db] * v[db]; }
            ss += __shfl_xor(ss, 1); ss += __shfl_xor(ss, 2); ss += __shfl_xor(ss, 4); ss += __shfl_xor(ss, 8); ss += __shfl_xor(ss, 16);
            const float rs = 1.0f / sqrtf(ss * (1.0f / 128.0f) + 1e-5f);
            bf16_t* op = ob + crow0(r) * DM;
#pragma unroll
            for (int db = 0; db < 4; ++db) op[db * 32] = (bf16_t)(cvtpk(v[db] * rs * g[db], 0.f) & 0xffffu);
        }
    }
    __syncthreads();
}
__device__ __forceinline__ void diff_prompt_unit(const Ctx& c0, int b, int h, int qb) {
    Ctx c = c0; c.lane = pg8::lane_late(); c.tid = c.wid * 64 + c.lane; c.r32 = c.lane & 31; c.hi = c.lane >> 5;
    const int q0 = qb * 128, NT = qb * 2 + 2, wq = c.wid & 3, tlast = qb * 2 + (wq >> 1);
    const size_t rowb = (size_t)b * SEQ;
    const size_t qrow = rowb + q0 + wq * 32 + c.r32;
    DiffState S; diff_init(S, c, c.Z + qrow * NZ + h * 128 + (c.wid >> 2) * 64);
    const float cfar = ((const LAS float*)(c.lds + L_T5))[h * 512 + 448 - 100];
    const bf16_t* k1src = c.Z + (rowb + c.lane) * NZ + 512 + h * 128 + c.wid * 8;
    const bf16_t* vsrc0 = c.Z + (rowb + 16 * (c.wid & 3) + (c.lane >> 2)) * NZ + 1024 + h * 128 + (c.wid >> 2) * 32 + (c.lane & 3) * 8;
    const int wofs = c.wid * 1024 + c.lane * 16;
    u32x4 r0, r1, r2, r3;
#define DP_LOAD(t) do { const size_t o_ = (size_t)(t) * 64 * NZ; r0 = *(const u32x4*)(k1src + o_); r1 = *(const u32x4*)(k1src + o_ + 64); r2 = *(const u32x4*)(vsrc0 + o_); r3 = *(const u32x4*)(vsrc0 + o_ + 64); } while (0)
#define DP_WRITE(buf) do { ldsp s_ = c.lds + (buf) * 32768; *(LAS u32x4*)(s_ + wofs) = r0; *(LAS u32x4*)(s_ + 8192 + wofs) = r1; *(LAS u32x4*)(s_ + 16384 + wofs) = r2; *(LAS u32x4*)(s_ + 16384 + 8192 + wofs) = r3; } while (0)
    DP_LOAD(0); DP_WRITE(0); __syncthreads();
    for (int t = 0; t < NT; ++t) {
        if (t + 1 < NT) DP_LOAD(t + 1);
        if (t <= tlast) {
            ldscp slot = c.lds + (t & 1) * 32768;
            if (t >= qb * 2 - 2) diff_tile<true>(S, c, slot, cfar, h, 64 * t - (q0 + wq * 32 + c.r32) + 448, false);
            else diff_tile<false>(S, c, slot, cfar, h, 0, false);
        }
        if (t + 1 < NT) DP_WRITE((t + 1) & 1);
        __syncthreads();
    }
#undef DP_LOAD
#undef DP_WRITE
    diff_finish(S, c, h, rowb + q0 + wq * 32, true);
}
__device__ __forceinline__ void diff_sample_unit(const Ctx& c0, int b, int h) {
    Ctx c = c0; c.lane = pg8::lane_late(); c.tid = c.wid * 64 + c.lane; c.r32 = c.lane & 31; c.hi = c.lane >> 5;
    const size_t qrow = (size_t)MP + b * SS + c.r32;
    DiffState S; diff_init(S, c, c.Z + qrow * NZ + h * 128 + (c.wid >> 2) * 64);
    const float cfar = ((const LAS float*)(c.lds + L_T5))[h * 512 + 448 - 100];
    const int wofs = c.wid * 1024 + c.lane * 16;
    const bool active = (c.wid & 3) == 0;
    for (int t = 0; t <= 16; ++t) {
        u32x4 r0, r1, r2, r3;
        if (t < 16) {
            const float* ks = c.cak + (((size_t)(b * PAST + 64 * t + c.lane) * 4 + h) * 2) * 64 + c.wid * 8;
            r0 = cvt8(*(const f32x4*)ks, *(const f32x4*)(ks + 4)); r1 = cvt8(*(const f32x4*)(ks + 64), *(const f32x4*)(ks + 68));
            __builtin_amdgcn_sched_barrier(0);
            const float* vs = c.cav + ((size_t)(b * PAST + 64 * t + 16 * (c.wid & 3) + (c.lane >> 2)) * 4 + h) * 128 + (c.wid >> 2) * 32 + (c.lane & 3) * 8;
            r2 = cvt8(*(const f32x4*)vs, *(const f32x4*)(vs + 4)); r3 = cvt8(*(const f32x4*)(vs + 64), *(const f32x4*)(vs + 68));
        } else {
            const u32x4 z4 = (u32x4){0u, 0u, 0u, 0u};
            r0 = z4; r1 = z4; r2 = z4; r3 = z4;
            if (c.lane < 32) { const bf16_t* ks = c.Z + ((size_t)MP + b * SS + c.lane) * NZ + 512 + h * 128 + c.wid * 8; r0 = *(const u32x4*)ks; r1 = *(const u32x4*)(ks + 64); }
            const int vk = 16 * (c.wid & 3) + (c.lane >> 2);
            if (vk < 32) { const bf16_t* vs = c.Z + ((size_t)MP + b * SS + vk) * NZ + 1024 + h * 128 + (c.wid >> 2) * 32 + (c.lane & 3) * 8; r2 = *(const u32x4*)vs; r3 = *(const u32x4*)(vs + 64); }
        }
        ldsp s_ = c.lds;
        *(LAS u32x4*)(s_ + wofs) = r0; *(LAS u32x4*)(s_ + 8192 + wofs) = r1; *(LAS u32x4*)(s_ + 16384 + wofs) = r2; *(LAS u32x4*)(s_ + 16384 + 8192 + wofs) = r3;
        __builtin_amdgcn_sched_barrier(0);
        __syncthreads();
        if (active) {
            const int relb = 64 * t - (PAST + c.r32) + 448;
            if (t >= 14) diff_tile<true>(S, c, c.lds, cfar, h, relb, t == 16);
            else diff_tile<false>(S, c, c.lds, cfar, h, 0, false);
        }
        __syncthreads();
    }
    diff_finish(S, c, h, (size_t)MP + b * SS, active);
}


#define SBAR() __builtin_amdgcn_sched_barrier(0)
#define PIN(x) asm volatile("" : "+v"(x))
#define WAIT_BAR(N) asm volatile("s_waitcnt vmcnt(" #N ") lgkmcnt(0)\n\ts_barrier" ::: "memory")
__device__ __forceinline__ void glds16(const void* gsrc, unsigned lds_dst) { unsigned keep;
    asm volatile("s_mov_b32 %0, m0\n\ts_mov_b32 m0, %2\n\ts_nop 0\n\tglobal_load_lds_dwordx4 %1, off\n\ts_mov_b32 m0, %0" : "=&s"(keep) : "v"(gsrc), "s"(lds_dst) : "memory"); }
__device__ __forceinline__ void kload8(bf16x8* kf, ldscp kp) {
    kf[0] = *(const LAS bf16x8*)(kp);        kf[1] = *(const LAS bf16x8*)(kp + 512);
    kf[2] = *(const LAS bf16x8*)(kp + 2048); kf[3] = *(const LAS bf16x8*)(kp + 2560);
    kf[4] = *(const LAS bf16x8*)(kp + 4096); kf[5] = *(const LAS bf16x8*)(kp + 4608);
    kf[6] = *(const LAS bf16x8*)(kp + 6144); kf[7] = *(const LAS bf16x8*)(kp + 6656);
}
__device__ __forceinline__ void kload2(bf16x8* kf, ldscp kp, int j) { kf[2 * j] = *(const LAS bf16x8*)(kp + j * 2048); kf[2 * j + 1] = *(const LAS bf16x8*)(kp + j * 2048 + 512); }

__device__ __forceinline__ void diff_prompt_unit2(const Ctx& c0, int b, int h, int qb) {
    Ctx c = c0; c.lane = pg8::lane_late(); c.tid = c.wid * 64 + c.lane; c.r32 = c.lane & 31; c.hi = c.lane >> 5;
    const int wq = c.wid & 3, map = c.wid >> 2, r32 = c.r32, hi = c.hi;
    const int q0 = qb * 128, NT = qb * 2 + 2, qchunk = NT - 2 + (wq >> 1);
    const size_t rowb = (size_t)b * SEQ;
    LAS float* wsf = (LAS float*)(c.lds + L_WSF) + c.wid * 64;
    const LAS float* t5 = (const LAS float*)(c.lds + L_T5) + h * 512;
    const float bfar = t5[448 - 100];
    const bf16_t* ksrc = c.Z + (rowb + c.lane) * NZ + 512 + h * 128 + c.wid * 8;
    const bf16_t* vsrc = c.Z + (rowb + 16 * (c.wid & 3) + (c.lane >> 2)) * NZ + 1024 + h * 128 + (c.wid >> 2) * 32 + (c.lane & 3) * 8;
    const unsigned lds0 = (unsigned)(uintptr_t)c.lds;
    const unsigned kdst = lds0 + c.wid * 1024, vdst = lds0 + 49152 + c.wid * 1024;
#define TCL(t) ((t) < NT ? (t) : NT - 1)
#define DMA_K(t, s) do { const size_t o_ = (size_t)TCL(t) * 64 * NZ; glds16(ksrc + o_, (unsigned)__builtin_amdgcn_readfirstlane(kdst + (s) * 8192)); glds16(ksrc + o_ + 64, (unsigned)__builtin_amdgcn_readfirstlane(kdst + 24576 + (s) * 8192)); } while (0)
#define DMA_V(t, s) do { const size_t o_ = (size_t)TCL(t) * 64 * NZ; glds16(vsrc + o_, (unsigned)__builtin_amdgcn_readfirstlane(vdst + (s) * 16384)); glds16(vsrc + o_ + 64, (unsigned)__builtin_amdgcn_readfirstlane(vdst + 8192 + (s) * 16384)); } while (0)
    ldscp kp0 = (ldscp)c.lds + map * 24576 + hi * 1024 + r32 * 16;
    ldscp vp0 = (ldscp)c.lds + 49152 + vlane_off(c.lane);
    DMA_K(0, 0); DMA_V(0, 0); DMA_K(1, 1);
    bf16x8 qf[4];
    { const bf16_t* qrow = c.Z + (rowb + q0 + wq * 32 + r32) * NZ + h * 128 + map * 64;
#pragma unroll
      for (int d0 = 0; d0 < 4; ++d0) qf[d0] = *(const bf16x8*)(qrow + d0 * 16 + hi * 8); }
    float mhat = NEGBIG, l_reg = 0.f; f32x16 o[4]; o[0] = f32x16{}; o[1] = f32x16{}; o[2] = f32x16{}; o[3] = f32x16{};
    const f32x16 zero = f32x16{};
    bool resc = false;
    const int relq = -(q0 + wq * 32 + r32) + 448 + 4 * hi;
    bf16x8 kf[8];
    f32x16 pA0, pA1, pB0, pB1;
    int sp = 0, sc = 0, sn = 1;
#define ROT() do { sp = sc; sc = sn; sn = (sn == 2) ? 0 : sn + 1; } while (0)
#define NEARFIX(C0, C1, t) do { if ((t) >= NT - 4) { const LAS float* tb_ = t5 + (relq + 64 * (t)); const float madd_ = (t) > qchunk ? NEGBIG : 0.f; \
        _Pragma("unroll") for (int r = 0; r < 16; ++r) { C0[r] += tb_[crow0(r)] + madd_; C1[r] += tb_[crow0(r) + 32] + madd_; } } } while (0)
#define MX3(a, b, c) __builtin_fmaxf(__builtin_fmaxf((a), (b)), (c))
#define DECIDE(C0, C1, bc, msub) do { \
        float a_ = MX3(C0[0], C0[1], C1[0]), b_ = MX3(C0[2], C0[3], C1[1]); a_ = MX3(a_, C1[2], C1[3]); \
        _Pragma("unroll") for (int r = 4; r < 16; r += 4) { a_ = MX3(a_, C0[r], C0[r + 1]); b_ = MX3(b_, C0[r + 2], C0[r + 3]); a_ = MX3(a_, C1[r], C1[r + 1]); b_ = MX3(b_, C1[r + 2], C1[r + 3]); } \
        float rm_ = __builtin_fmaxf(a_, b_); { auto rr_ = __builtin_amdgcn_permlane32_swap(__float_as_uint(rm_), __float_as_uint(rm_), false, false); rm_ = __builtin_fmaxf(__uint_as_float(rr_[0]), __uint_as_float(rr_[1])); } \
        rm_ += (bc); resc = false; \
        if (__builtin_expect(__any(rm_ > mhat + THR), 0)) { const float mn_ = __builtin_fmaxf(mhat, rm_); const float f_ = __builtin_amdgcn_exp2f(mhat - mn_); mhat = mn_; l_reg *= f_; if (hi == 0) wsf[r32] = f_; resc = true; } \
        msub = mhat - (bc); } while (0)
#define RESC() do { if (resc) { asm volatile("s_waitcnt lgkmcnt(0)" ::: "memory"); const LAS float* wq_ = wsf + 4 * hi; \
        _Pragma("unroll") for (int d_ = 0; d_ < 4; ++d_) _Pragma("unroll") for (int r = 0; r < 16; ++r) o[d_][r] *= wq_[crow0(r)]; } } while (0)
    DMA_K(2, 2);
    WAIT_BAR(6);
    qkt(pA0, pA1, (ldscp)c.lds + map * 24576, qf, zero, r32, hi);
    NEARFIX(pA0, pA1, 0);
    { float msub; const float bc0 = (0 >= NT - 4) ? 0.f : bfar; DECIDE(pA0, pA1, bc0, msub); resc = false;
#pragma unroll
      for (int r = 0; r < 16; ++r) { pA0[r] = __builtin_amdgcn_exp2f(pA0[r] - msub); pA1[r] = __builtin_amdgcn_exp2f(pA1[r] - msub); } }
    WAIT_BAR(0);
    DMA_K(3, 0); DMA_V(1, 1);
    ROT();
    kload8(kf, kp0 + sc * 8192);
    WAIT_BAR(4);
    s16x4 vlo[8], vhi[8]; u32x4 pw0, pw1, pw2, pw3;
#define PKW(P, B) cvtpk(P[B], P[B + 1])
#define PAF(k) __builtin_bit_cast(bf16x8, pw##k)
#define VFR(i) (bf16x8){vlo[i][0], vlo[i][1], vlo[i][2], vlo[i][3], vhi[i][0], vhi[i][1], vhi[i][2], vhi[i][3]}
#define VRD(i, f) do { vlo[i] = vtr(vp_ + (((f) & 3) * 4096 + ((f) >> 2) * 1024)); vhi[i] = vtr(vp_ + (((f) & 3) * 4096 + ((f) >> 2) * 1024 + 512)); } while (0)
#define GAPA(MF, A0, A1, A2, A3, W0, W1, PW) do { MF; sacc += A0; sacc += A1; sacc += A2; sacc += A3; PIN(sacc); W0; W1; PIN(PW); SBAR(); } while (0)
#define EXS(v) __builtin_amdgcn_exp2f((v) - msub)
#define GAPB(MF, X, B) do { MF; X[B] = EXS(X[B]); X[B + 1] = EXS(X[B + 1]); PIN(X); SBAR(); } while (0)
#define KRD(j) do { kload2(kf, kp0 + sn * 8192, j); SBAR(); } while (0)
#define MF32(a, b, cc) __builtin_amdgcn_mfma_f32_32x32x16_bf16(a, b, cc, 0, 0, 0)
#define STEP(C0, C1, P0, P1, t, NEARF) do { SBAR(); \
        ldscp vp_ = vp0 + sp * 16384; float msub; \
        VRD(0, 0); SBAR(); float sacc = (P0[0] + P0[1]); \
        GAPA(C0 = MF32(kf[0], qf[0], zero), P0[2], P0[3], P0[4], P0[5],     pw0[0] = PKW(P0, 0), pw0[1] = PKW(P0, 2), pw0); \
        VRD(1, 1); SBAR(); GAPA(C1 = MF32(kf[1], qf[0], zero), P0[6], P0[7], P0[8], P0[9],     pw0[2] = PKW(P0, 4), pw0[3] = PKW(P0, 6), pw0); \
        VRD(2, 2); SBAR(); GAPA(C0 = MF32(kf[2], qf[1], C0),   P0[10], P0[11], P0[12], P0[13], pw1[0] = PKW(P0, 8), pw1[1] = PKW(P0, 10), pw1); \
        VRD(3, 3); SBAR(); GAPA(C1 = MF32(kf[3], qf[1], C1),   P0[14], P0[15], P1[0], P1[1],   pw1[2] = PKW(P0, 12), pw1[3] = PKW(P0, 14), pw1); \
        VRD(4, 4); SBAR(); GAPA(C0 = MF32(kf[4], qf[2], C0),   P1[2], P1[3], P1[4], P1[5],     pw2[0] = PKW(P1, 0), pw2[1] = PKW(P1, 2), pw2); \
        VRD(5, 5); SBAR(); GAPA(C1 = MF32(kf[5], qf[2], C1),   P1[6], P1[7], P1[8], P1[9],     pw2[2] = PKW(P1, 4), pw2[3] = PKW(P1, 6), pw2); \
        VRD(6, 6); SBAR(); GAPA(C0 = MF32(kf[6], qf[3], C0),   P1[10], P1[11], P1[12], P1[13], pw3[0] = PKW(P1, 8), pw3[1] = PKW(P1, 10), pw3); \
        VRD(7, 7); SBAR(); GAPA(C1 = MF32(kf[7], qf[3], C1),   P1[14], P1[15], 0.f, 0.f,       pw3[2] = PKW(P1, 12), pw3[3] = PKW(P1, 14), pw3); \
        l_reg += sacc; \
        DMA_K((t) + 3, sc); DMA_V((t) + 1, sn); \
        if (NEARF) NEARFIX(C0, C1, t); \
        { const float bc_ = (NEARF && (t) >= NT - 4) ? 0.f : bfar; DECIDE(C0, C1, bc_, msub); } \
        SBAR(); \
        GAPB(o[0] = MF32(PAF(0), VFR(0), o[0]), C0, 0);  VRD(0, 8);  SBAR(); \
        GAPB(o[1] = MF32(PAF(0), VFR(1), o[1]), C0, 2);  VRD(1, 9);  SBAR(); \
        GAPB(o[2] = MF32(PAF(0), VFR(2), o[2]), C0, 4);  VRD(2, 10); SBAR(); \
        GAPB(o[3] = MF32(PAF(0), VFR(3), o[3]), C0, 6);  VRD(3, 11); SBAR(); \
        GAPB(o[0] = MF32(PAF(1), VFR(4), o[0]), C0, 8);  VRD(4, 12); SBAR(); \
        GAPB(o[1] = MF32(PAF(1), VFR(5), o[1]), C0, 10); VRD(5, 13); SBAR(); \
        GAPB(o[2] = MF32(PAF(1), VFR(6), o[2]), C0, 12); VRD(6, 14); SBAR(); \
        GAPB(o[3] = MF32(PAF(1), VFR(7), o[3]), C0, 14); VRD(7, 15); SBAR(); \
        GAPB(o[0] = MF32(PAF(2), VFR(0), o[0]), C1, 0); \
        GAPB(o[1] = MF32(PAF(2), VFR(1), o[1]), C1, 2); \
        KRD(0); GAPB(o[2] = MF32(PAF(2), VFR(2), o[2]), C1, 4); \
        KRD(1); GAPB(o[3] = MF32(PAF(2), VFR(3), o[3]), C1, 6); \
        KRD(2); GAPB(o[0] = MF32(PAF(3), VFR(4), o[0]), C1, 8); \
        KRD(3); GAPB(o[1] = MF32(PAF(3), VFR(5), o[1]), C1, 10); \
        GAPB(o[2] = MF32(PAF(3), VFR(6), o[2]), C1, 12); \
        GAPB(o[3] = MF32(PAF(3), VFR(7), o[3]), C1, 14); \
    } while (0)
    int t = 1;
    for (; t + 5 < NT; t += 2) {
        STEP(pB0, pB1, pA0, pA1, t, 0);     WAIT_BAR(4); RESC(); ROT();
        STEP(pA0, pA1, pB0, pB1, t + 1, 0); WAIT_BAR(4); RESC(); ROT();
    }
    for (; t + 1 < NT; t += 2) {
        STEP(pB0, pB1, pA0, pA1, t, 1);     WAIT_BAR(4); RESC(); ROT();
        STEP(pA0, pA1, pB0, pB1, t + 1, 1); WAIT_BAR(4); RESC(); ROT();
    }
    STEP(pB0, pB1, pA0, pA1, NT - 1, 1); WAIT_BAR(4); RESC();
    { float sacc = pB0[0] + pB0[1];
#pragma unroll
      for (int r = 2; r < 16; ++r) sacc += pB0[r];
#pragma unroll
      for (int r = 0; r < 16; ++r) sacc += pB1[r];
      l_reg += sacc;
      u32x4 pw[4]; packp(pw, pB0, pB1);
      ldscp vp_ = vp0 + sc * 16384;
      SBAR();
#pragma unroll
      for (int db = 0; db < 4; ++db) {
#pragma unroll
          for (int ks = 0; ks < 4; ++ks) { const bf16x8 vf = vfrag(vp_, db, ks); o[db] = MF32(__builtin_bit_cast(bf16x8, pw[ks]), vf, o[db]); }
          SBAR();
      } }
    asm volatile("s_waitcnt vmcnt(0) lgkmcnt(0)\n\ts_barrier" ::: "memory");
#undef TCL
#undef DMA_K
#undef DMA_V
#undef ROT
#undef NEARFIX
#undef MX3
#undef DECIDE
#undef RESC
#undef PKW
#undef PAF
#undef VFR
#undef VRD
#undef GAPA
#undef EXS
#undef GAPB
#undef KRD
#undef MF32
#undef STEP
    DiffState S; S.m = mhat; S.l = l_reg; S.o[0] = o[0]; S.o[1] = o[1]; S.o[2] = o[2]; S.o[3] = o[3];
    diff_finish(S, c, h, rowb + q0 + wq * 32, true);
}
#undef SBAR
#undef PIN
#undef WAIT_BAR

template <int NQ> __device__ __forceinline__ void band_unit(const Ctx& c0, int b, int ch) {
    Ctx c = c0; c.lane = pg8::lane_late(); c.tid = c.wid * 64 + c.lane; c.r32 = c.lane & 31; c.hi = c.lane >> 5;
    const int h = c.wid;
    constexpr bool SAMPLE = (NQ == 1);
    const size_t qrow0 = SAMPLE ? (size_t)MP + b * SS : (size_t)b * SEQ + ch * 64;
    LAS float* wsf = (LAS float*)(c.lds + L_WSF) + c.wid * 64;
    const LAS float* bt = (const LAS float*)(c.lds + L_BT) + h * 264;
    ldsp ks = c.lds + c.wid * 16384; ldsp vs = ks + 8192;
    bf16x8 qr[NQ][4]; float mh[NQ], l[NQ]; f32x16 o[NQ][2];
#pragma unroll
    for (int q = 0; q < NQ; ++q) {
        mh[q] = NEGBIG; l[q] = 0.f; o[q][0] = f32x16{}; o[q][1] = f32x16{};
        const bf16_t* qp = c.Z + (qrow0 + q * 32 + c.r32) * NZ + 1536 + h * 64;
#pragma unroll
        for (int d0 = 0; d0 < 4; ++d0) qr[q][d0] = *(const bf16x8*)(qp + d0 * 16 + c.hi * 8);
    }
    const int jt0 = SAMPLE ? 0 : (ch >= 8 ? 0 : 8 - ch);
    const f32x16 zero = f32x16{};
    for (int jt = jt0; jt <= 8; ++jt) {
        bool half = false;
        if (!SAMPLE || jt == 8) {
            const size_t krow0 = SAMPLE ? (size_t)MP + b * SS : (size_t)b * SEQ + (size_t)(ch - 8 + jt) * 64;
            if (SAMPLE) half = true;
#pragma unroll 2
            for (int p = 0; p < 8; ++p) {
                u32x4 kv = (u32x4){0u, 0u, 0u, 0u}, vv = kv;
                if (!SAMPLE || c.lane < 32) kv = *(const u32x4*)(c.Z + (krow0 + c.lane) * NZ + 2048 + h * 64 + p * 8);
                const int vk = 16 * (p & 3) + (c.lane >> 2);
                if (!SAMPLE || vk < 32) vv = *(const u32x4*)(c.Z + (krow0 + vk) * NZ + 2560 + h * 64 + (p >> 2) * 32 + (c.lane & 3) * 8);
                *(LAS u32x4*)(ks + p * 1024 + c.lane * 16) = kv; *(LAS u32x4*)(vs + p * 1024 + c.lane * 16) = vv;
            }
        } else {
#pragma unroll 1
            for (int p = 0; p < 8; ++p) {
                const float* kp = c.cbk + ((size_t)(b * CBL + jt * 64 + c.lane) * 8 + h) * 64 + p * 8;
                const float* vp = c.cbv + ((size_t)(b * CBL + jt * 64 + 16 * (p & 3) + (c.lane >> 2)) * 8 + h) * 64 + (p >> 2) * 32 + (c.lane & 3) * 8;
                *(LAS u32x4*)(ks + p * 1024 + c.lane * 16) = cvt8(*(const f32x4*)kp, *(const f32x4*)(kp + 4));
                *(LAS u32x4*)(vs + p * 1024 + c.lane * 16) = cvt8(*(const f32x4*)vp, *(const f32x4*)(vp + 4));
            }
        }
        __builtin_amdgcn_sched_barrier(0);
        u32x4 pw[NQ][4];
#pragma unroll
        for (int q = 0; q < NQ; ++q) {
            f32x16 p0, p1;
            qkt(p0, p1, ks, qr[q], zero, c.r32, c.hi);
            const int relb = SAMPLE ? (jt == 8 ? -c.r32 : 64 * jt - 512 - c.r32) : (jt - 8) * 64 - (q * 32 + c.r32);
            const int relh = relb + 4 * c.hi;
#pragma unroll
            for (int r = 0; r < 16; ++r) {
                int i0 = relh + crow0(r), i1 = relh + crow0(r) + 32;
                i0 = (i0 < -128 ? -128 : (i0 > 128 ? 128 : i0)) + 128; i1 = (i1 < -128 ? -128 : (i1 > 128 ? 128 : i1)) + 128;
                p0[r] += bt[i0]; p1[r] += bt[i1];
            }
            if (half) {
#pragma unroll
                for (int r = 0; r < 16; ++r) p1[r] = NEGBIG;
            }
            softmax_step<2>(p0, p1, mh[q], l[q], o[q], wsf, c.r32, c.hi, 0.f);
            packp(pw[q], p0, p1);
        }
        ldscp vp = vs + vlane_off(c.lane);
        __builtin_amdgcn_sched_barrier(0);
#pragma unroll
        for (int db = 0; db < 2; ++db) {
#pragma unroll
            for (int ksx = 0; ksx < 4; ++ksx) {
                const bf16x8 vf = vfrag(vp, db, ksx);
#pragma unroll
                for (int q = 0; q < NQ; ++q) o[q][db] = __builtin_amdgcn_mfma_f32_32x32x16_bf16(__builtin_bit_cast(bf16x8, pw[q][ksx]), vf, o[q][db], 0, 0, 0);
            }
            __builtin_amdgcn_sched_barrier(0);
        }
    }
    LAS float* xch = (LAS float*)(c.lds + L_XCH);
    float rl[NQ][16];
#pragma unroll
    for (int q = 0; q < NQ; ++q) {
        const float lt = l[q] + __shfl_xor(l[q], 32);
        if (c.hi == 0) wsf[c.r32] = 1.0f / lt;
#pragma unroll
        for (int r = 0; r < 16; ++r) rl[q][r] = (wsf + 4 * c.hi)[crow0(r)];
#pragma unroll
        for (int r = 0; r < 16; ++r) {
            o[q][0][r] *= rl[q][r]; o[q][1][r] *= rl[q][r];
            float ss = o[q][0][r] * o[q][0][r] + o[q][1][r] * o[q][1][r];
            ss += __shfl_xor(ss, 1); ss += __shfl_xor(ss, 2); ss += __shfl_xor(ss, 4); ss += __shfl_xor(ss, 8); ss += __shfl_xor(ss, 16);
            if (c.r32 == 0) (xch + (q * 32 + 4 * c.hi) * 8 + h)[crow0(r) * 8] = ss;
        }
    }
    __syncthreads();
    const float g0 = c.onb[h * 64 + c.r32], g1 = c.onb[h * 64 + 32 + c.r32];
#pragma unroll
    for (int q = 0; q < NQ; ++q)
#pragma unroll
        for (int r = 0; r < 16; ++r) {
            const LAS float* xr = xch + (q * 32 + 4 * c.hi) * 8 + crow0(r) * 8;
            const f32x4 a = *(const LAS f32x4*)(xr), bq = *(const LAS f32x4*)(xr + 4);
            const float tot = ((a[0] + a[1]) + (a[2] + a[3])) + ((bq[0] + bq[1]) + (bq[2] + bq[3]));
            const float rs = 1.0f / sqrtf(tot * (1.0f / 512.0f) + 1e-6f);
            bf16_t* op = c.AO + (qrow0 + q * 32 + 4 * c.hi) * DM + 512 + h * 64 + c.r32 + crow0(r) * DM;
            op[0] = (bf16_t)(cvtpk(o[q][0][r] * rs * g0, 0.f) & 0xffffu);
            op[32] = (bf16_t)(cvtpk(o[q][1][r] * rs * g1, 0.f) & 0xffffu);
        }
    __syncthreads();
}
#undef LAS
}

#define LAS __attribute__((address_space(3)))
typedef unsigned short bf16;
typedef float f32x4 __attribute__((ext_vector_type(4)));
typedef unsigned v4u __attribute__((ext_vector_type(4)));
constexpr int NWAVES = 8, NTHREADS = NWAVES * 64;
constexpr int LDS_BYTES = 155648;
constexpr int L_MISC = att::L_END;
static_assert(L_MISC + 64 <= LDS_BYTES, "LDS map");
#ifndef MK_MULTI
#define MK_MULTI 0
#endif
#ifndef REP_BAND
#define REP_BAND 1
#endif
#ifndef REP_SAMP
#define REP_SAMP 1
#endif
#ifndef REP_DIFF
#define REP_DIFF 1
#endif
#ifndef REP_GEMM
#define REP_GEMM 1
#endif
constexpr int N_PHASES = 8;
constexpr size_t MiB = 1u << 20;
constexpr size_t WS_WIN = 0, WS_WOUT = 6 * MiB, WS_WUP = 8 * MiB, WS_WDN = 16 * MiB, WS_WG = 24 * MiB, WS_WP = 26 * MiB;
constexpr size_t WS_CTL = 26 * MiB + 512 * 1024, CTL_BYTES = 16384;
constexpr size_t WS_SS1 = 27 * MiB, WS_SS2 = 30 * MiB;
constexpr size_t WS_PB = 33 * MiB;
constexpr size_t WS_B = 50 * MiB;
constexpr size_t WS_C = 116 * MiB;
constexpr size_t WS_A = 182 * MiB;
constexpr size_t WS_END = WS_A + (size_t)MT * DFF * 2;
static_assert(WS_END <= 512 * MiB && WS_PB + (size_t)MT * DPLE * 2 <= WS_B && WS_B + (size_t)MT * DM * 2 <= WS_C && WS_C + (size_t)MT * DM * 2 <= WS_A && WS_SS2 + (size_t)MT * 64 <= WS_PB, "d_ws map");

#define XB_TMO      128
#define XB_XCNT(j)  (256  + 64 * (j))
#define XB_XSUB(j)  (1280 + 64 * (j))
#define XB_XGEN(j)  (2304 + 64 * (j))
#define XB_TOP      3328
#define XB_TOPGEN   3392
#define XCD_BAR_WORDS 3456
#define XB_SPIN_CAP (1u << 24)
__device__ __forceinline__ unsigned xb_ld(unsigned* p)              { return __hip_atomic_load(p, __ATOMIC_RELAXED, __HIP_MEMORY_SCOPE_AGENT); }
__device__ __forceinline__ unsigned xb_add(unsigned* p, unsigned v) { return __hip_atomic_fetch_add(p, v, __ATOMIC_RELAXED, __HIP_MEMORY_SCOPE_AGENT); }
__device__ __forceinline__ unsigned xb_xcc_id() { return (unsigned)__builtin_amdgcn_s_getreg((3 << 11) | 20) & 0xFu; }
#define XB_SPIN(cond, bar) do { unsigned _sp = 0; while (cond) { __builtin_amdgcn_s_sleep(1); \
    if ((++_sp & 255u) == 0u) { if (xb_ld(&(bar)[XB_TMO])) break; if (_sp > XB_SPIN_CAP) { atomicAdd(&(bar)[XB_TMO], 1u); break; } } } } while (0)
struct XcdBarrier { unsigned* bar; unsigned x; volatile LAS unsigned* st; };
__device__ __forceinline__ void xcd_barrier_complete(unsigned* bar, unsigned x, unsigned& nloc, unsigned& nx) {
    const unsigned G = gridDim.x;
    unsigned sum, cnt, mine, sp = 0u;
    for (;;) {
        sum = 0u; cnt = 0u; mine = 0u;
#pragma unroll
        for (unsigned j = 0; j < 16; ++j) { const unsigned c = xb_ld(&bar[XB_XCNT(j)]); sum += c; cnt += (c > 0u) ? 1u : 0u; mine = (j == x) ? c : mine; }
        if (sum == G) break;
        __builtin_amdgcn_s_sleep(1);
        if ((++sp & 255u) == 0u) { if (xb_ld(&bar[XB_TMO])) break; if (sp > XB_SPIN_CAP) { atomicAdd(&bar[XB_TMO], 1u); break; } }
    }
    nloc = mine > 0u ? mine : 1u; nx = cnt > 0u ? cnt : 1u;
}
__device__ __forceinline__ void xcd_barrier(const XcdBarrier& b, bool leader) {
    asm volatile("s_waitcnt vmcnt(0)" ::: "memory");
    __syncthreads();
    if (leader) {
        unsigned* bar = b.bar;
        __builtin_amdgcn_s_waitcnt(0);
        unsigned nloc = b.st[0], nx = b.st[1];
        if (nloc == 0u) { xcd_barrier_complete(bar, b.x, nloc, nx); b.st[0] = nloc; b.st[1] = nx; }
        const unsigned old = xb_add(&bar[XB_XSUB(b.x)], 1u);
        const unsigned gen = old / nloc;
        if (old + 1u == (gen + 1u) * nloc) {
            __builtin_amdgcn_fence(__ATOMIC_RELEASE, "agent");
            asm volatile("s_waitcnt vmcnt(0)" ::: "memory");
            const unsigned og = xb_add(&bar[XB_TOP], 1u);
            const unsigned tg = og / nx;
            if (og + 1u == (tg + 1u) * nx) xb_add(&bar[XB_TOPGEN], 1u);
            else XB_SPIN(xb_ld(&bar[XB_TOPGEN]) == tg, bar);
            __builtin_amdgcn_fence(__ATOMIC_ACQUIRE, "agent");
            xb_add(&bar[XB_XGEN(b.x)], 1u);
            asm volatile("s_waitcnt vmcnt(0)" ::: "memory");
        } else {
            XB_SPIN(xb_ld(&bar[XB_XGEN(b.x)]) == gen, bar);
            __builtin_amdgcn_fence(__ATOMIC_ACQUIRE, "agent");
            asm volatile("s_waitcnt vmcnt(0)" ::: "memory");
        }
    }
    __syncthreads();
}

struct Args {
    const float *xp, *xs, *cak, *cav, *cbk, *cbv, *pp, *ps, *t5, *g_attn, *w_in, *lq1, *lk1, *lq2, *lk2, *subln, *bandt, *onb, *w_out, *g_mlp, *w_up, *w_down, *w_gate, *w_proj, *g_final;
    float* out; unsigned char* ws; int ph_lo, ph_hi;
};

__device__ __forceinline__ float wave_sum(float v) {
#pragma unroll
    for (int o = 1; o < 64; o <<= 1) v += __shfl_xor(v, o);
    return v;
}
__device__ __forceinline__ void p0_transpose_item(const float* W, int K, int N, bf16* WT, const float* kscale, LAS float* scr, int item, int lane) {
    const int nblk = N / 32, kb = item / nblk, nb = item % nblk, k0 = 64 * kb, n0 = 32 * nb;
#pragma unroll 8
    for (int i = 0; i < 32; ++i) { const int kk = 2 * i + (lane >> 5); float v = W[(size_t)(k0 + kk) * N + n0 + (lane & 31)]; if (kscale) v *= kscale[k0 + kk]; scr[kk * 33 + (lane & 31)] = v; }
    asm volatile("s_waitcnt lgkmcnt(0)" ::: "memory");
    const int c = lane & 7;
#pragma unroll
    for (int j = 0; j < 4; ++j) { const int n = (lane >> 3) + 8 * j; const LAS float* s = scr + (8 * c) * 33 + n;
        v4u o; o.x = pg8::cvt_pk_bf16(s[0 * 33], s[1 * 33]); o.y = pg8::cvt_pk_bf16(s[2 * 33], s[3 * 33]); o.z = pg8::cvt_pk_bf16(s[4 * 33], s[5 * 33]); o.w = pg8::cvt_pk_bf16(s[6 * 33], s[7 * 33]);
        *(v4u*)(WT + (size_t)(n0 + n) * K + k0 + 8 * c) = o; }
    asm volatile("s_waitcnt lgkmcnt(0)" ::: "memory");
}

__global__ void __launch_bounds__(NTHREADS, 2) mk_fwd(Args a) {
    extern __shared__ __attribute__((aligned(16))) unsigned char lds_raw[];
    LAS unsigned char* lds = (LAS unsigned char*)lds_raw;
    const int G = gridDim.x, bid = blockIdx.x;
    const int wave = __builtin_amdgcn_readfirstlane(threadIdx.x >> 6);
    XcdBarrier xbar; xbar.bar = (unsigned*)(a.ws + WS_CTL); xbar.x = xb_xcc_id(); xbar.st = (volatile LAS unsigned*)(lds + L_MISC);
#if !MK_MULTI
    { const int l0 = pg8::lane_late();
      if (wave == 0 && l0 < 2) xbar.st[l0] = 0u;
      if (wave == 0 && l0 == 0) (void)xb_add(&xbar.bar[XB_XCNT(xbar.x)], 1u);
      __syncthreads(); }
#endif
#define TID_HERE() const int lane = pg8::lane_late(), tid = wave * 64 + lane; (void)tid
    unsigned char* ws = a.ws;
    bf16 *Win_t = (bf16*)(ws + WS_WIN), *Wout_t = (bf16*)(ws + WS_WOUT), *Wup_t = (bf16*)(ws + WS_WUP), *Wdn_t = (bf16*)(ws + WS_WDN), *Wg_t = (bf16*)(ws + WS_WG), *Wp_t = (bf16*)(ws + WS_WP);
    float *SS1 = (float*)(ws + WS_SS1), *SS2 = (float*)(ws + WS_SS2);
    bf16 *PB = (bf16*)(ws + WS_PB), *XN = (bf16*)(ws + WS_B), *AO = (bf16*)(ws + WS_B), *PP = (bf16*)(ws + WS_B), *HB = (bf16*)(ws + WS_C), *Z = (bf16*)(ws + WS_A), *U = (bf16*)(ws + WS_A);
    float* Y = a.out + O_Y;
    const int lo = a.ph_lo, hi = a.ph_hi;
#ifndef PH_MASK
#define PH_MASK 0xff
#endif
#define IN(k) (((PH_MASK >> (k)) & 1) && lo <= (k) && (k) < hi)
#if MK_MULTI
#define GRID_BAR() do {} while (0)
#else
#define GRID_BAR() do { const bool ldr_ = (wave == 0) && (pg8::lane_late() == 0); xcd_barrier(xbar, ldr_); } while (0)
#endif

    if (IN(0)) {
        TID_HERE();
        LAS float* scr = (LAS float*)(lds + wave * 16384);
        const int gw = bid * NWAVES + wave, NGW = G * NWAVES;
        constexpr int I_IN = (DM / 64) * (NZ / 32), I_OUT = (DM / 64) * (DM / 32), I_UP = (DM / 64) * (DFF / 32), I_DN = (DFF / 64) * (DM / 32), I_G = I_OUT, I_P = (DPLE / 64) * (DM / 32);
        constexpr int NITEMS = I_IN + I_OUT + I_UP + I_DN + I_G + I_P;
        for (int it = gw; it < NITEMS; it += NGW) {
            int r = it;
            if (r < I_IN) { p0_transpose_item(a.w_in, DM, NZ, Win_t, nullptr, scr, r, lane); continue; } r -= I_IN;
            if (r < I_OUT) { p0_transpose_item(a.w_out, DM, DM, Wout_t, nullptr, scr, r, lane); continue; } r -= I_OUT;
            if (r < I_UP) { p0_transpose_item(a.w_up, DM, DFF, Wup_t, a.g_mlp, scr, r, lane); continue; } r -= I_UP;
            if (r < I_DN) { p0_transpose_item(a.w_down, DFF, DM, Wdn_t, nullptr, scr, r, lane); continue; } r -= I_DN;
            if (r < I_G) { p0_transpose_item(a.w_gate, DM, DM, Wg_t, nullptr, scr, r, lane); continue; } r -= I_G;
            p0_transpose_item(a.w_proj, DPLE, DM, Wp_t, nullptr, scr, r, lane);
        }
        for (int m = gw; m < MT; m += NGW) {
            const float* xr = m < MP ? a.xp + (size_t)m * DM : a.xs + (size_t)(m - MP) * DM;
            f32x4 v[4], g[4]; float s = 0.f;
#pragma unroll
            for (int j = 0; j < 4; ++j) { v[j] = ((const f32x4*)xr)[lane + 64 * j]; g[j] = ((const f32x4*)a.g_attn)[lane + 64 * j]; s += (v[j][0] * v[j][0] + v[j][1] * v[j][1]) + (v[j][2] * v[j][2] + v[j][3] * v[j][3]); }
            const float rstd = 1.0f / sqrtf(wave_sum(s) * (1.0f / DM) + 1e-6f);
            unsigned long long* o8 = (unsigned long long*)(XN + (size_t)m * DM);
#pragma unroll
            for (int j = 0; j < 4; ++j) o8[lane + 64 * j] = (unsigned long long)pg8::cvt_pk_bf16(v[j][0] * rstd * g[j][0], v[j][1] * rstd * g[j][1]) | ((unsigned long long)pg8::cvt_pk_bf16(v[j][2] * rstd * g[j][2], v[j][3] * rstd * g[j][3]) << 32);
            const float* pr = m < MP ? a.pp + (size_t)m * DPLE : a.ps + (size_t)(m - MP) * DPLE;
            const f32x4 pv = ((const f32x4*)pr)[lane];
            ((unsigned long long*)(PB + (size_t)m * DPLE))[lane] = (unsigned long long)pg8::cvt_pk_bf16(pv[0], pv[1]) | ((unsigned long long)pg8::cvt_pk_bf16(pv[2], pv[3]) << 32);
        }
        if (IN(1)) GRID_BAR();
    }
    if (IN(1)) {
        pg8::Gemm g{XN, Win_t, MT, NZ, DM}; pg8::StaticOrder S; S.init(MT, NZ, G, bid);
        pg8::EpiQKV E{Z, a.out};
        pg8::gemm_phase<pg8::EpiQKV, pg8::StaticOrder, true, true>(lds, g, S, E, wave);
        if (IN(2)) GRID_BAR();
    }
    if (IN(2)) {
        TID_HERE();
        att::Ctx c; c.Z = Z; c.AO = AO; c.cak = a.cak; c.cav = a.cav; c.cbk = a.cbk; c.cbv = a.cbv; c.subln_g = a.subln; c.onb = a.onb;
        c.lds = lds; c.tid = tid; c.lane = lane; c.wid = wave; c.r32 = lane & 31; c.hi = lane >> 5;
        { float d1 = 0.f, d2 = 0.f;
          for (int i = 0; i < 64; ++i) { d1 += a.lq1[i] * a.lk1[i]; d2 += a.lq2[i] * a.lk2[i]; }
          c.lam = expf(d1) - expf(d2) + 0.2f; }
        for (int i = tid; i < 4 * 512; i += NTHREADS) { const int h = i >> 9, rel = (i & 511) - 448; ((LAS float*)(lds + att::L_T5))[i] = LOG2E * a.t5[att::t5_bucket(rel) * 4 + h]; }
        for (int i = tid; i < 8 * 264; i += NTHREADS) { const int h = i / 264, j = i % 264; ((LAS float*)(lds + att::L_BT))[i] = j <= 256 ? LOG2E * a.bandt[j * 8 + h] : 0.f; }
        __syncthreads();
#ifndef P2_MASK
#define P2_MASK 15
#endif
        for (int rep = 0; rep < REP_DIFF; ++rep)
        if (P2_MASK & 1) for (int u = bid; u < 1024; u += G) {
            const int v = u & 255, bh = v & 7, s = v >> 3, rnd = u >> 8, qb = rnd == 0 ? s : rnd == 1 ? 127 - s : rnd == 2 ? 63 - s : 64 + s;
            att::diff_prompt_unit2(c, bh >> 2, bh & 3, qb);
        }
        for (int rep = 0; rep < REP_BAND; ++rep)
        if (P2_MASK & 2) for (int u = bid; u < 512; u += G) att::band_unit<2>(c, u >> 8, u & 255);
        for (int rep = 0; rep < REP_SAMP; ++rep) {
        if (P2_MASK & 4) for (int u = bid; u < 64; u += G) att::diff_sample_unit(c, u >> 2, u & 3);
        if (P2_MASK & 8) for (int u = bid; u < 16; u += G) att::band_unit<1>(c, u, 0);
        }
        if (IN(3)) GRID_BAR();
    }
    if (IN(3)) {
        pg8::Gemm g{AO, Wout_t, MT, DM, DM}; pg8::StaticOrder S; S.init(MT, DM, G, bid);
        pg8::EpiOut E{a.xp, a.xs, Y, HB, SS1};
        pg8::gemm_phase<pg8::EpiOut, pg8::StaticOrder, true, true>(lds, g, S, E, wave);
        if (IN(4)) GRID_BAR();
    }
    if (IN(4)) {
        { pg8::Gemm g{HB, Wup_t, MT, DFF, DM}; pg8::StaticOrder S; S.init(MT, DFF, G, bid);
          pg8::EpiUp E{U, SS1};
          pg8::gemm_phase<pg8::EpiUp, pg8::StaticOrder, true, true>(lds, g, S, E, wave); }
        { int kp = DPLE; asm volatile("" : "+s"(kp));
          pg8::Gemm g{PB, Wp_t, MT, DM, kp}; pg8::StaticOrder S; S.init(MT, DM, G, bid);
          pg8::EpiPP E{PP};
          pg8::gemm_phase<pg8::EpiPP, pg8::StaticOrder, true, true>(lds, g, S, E, wave); }
        if (IN(5)) GRID_BAR();
    }
    if (IN(5)) {
        pg8::Gemm g{U, Wdn_t, MT, DM, DFF}; pg8::StaticOrder S; S.init(MT, DM, G, bid);
        pg8::EpiDown E{Y, HB};
        pg8::gemm_phase<pg8::EpiDown, pg8::StaticOrder, true, true>(lds, g, S, E, wave);
        if (IN(6)) GRID_BAR();
    }
    if (IN(6)) {
        pg8::Gemm g{HB, Wg_t, MT, DM, DM}; pg8::StaticOrder S; S.init(MT, DM, G, bid);
        pg8::EpiGate E{Y, PP, SS2};
        pg8::gemm_phase<pg8::EpiGate, pg8::StaticOrder, true, true>(lds, g, S, E, wave);
        if (IN(7)) GRID_BAR();
    }
    if (IN(7)) {
        TID_HERE();
        const int gw = bid * NWAVES + wave, NGW = G * NWAVES;
        for (int m = gw; m < MT; m += NGW) {
            float* yr = Y + (size_t)m * DM;
            const float sv = lane < 16 ? SS2[(size_t)m * 16 + lane] : 0.f;
            const float rstd = 1.0f / sqrtf(wave_sum(sv) * (1.0f / DM) + 1e-6f);
#pragma unroll
            for (int j = 0; j < 4; ++j) { const f32x4 v = ((const f32x4*)yr)[lane + 64 * j], g = ((const f32x4*)a.g_final)[lane + 64 * j]; ((f32x4*)yr)[lane + 64 * j] = v * rstd * g; }
        }
    }
#undef IN
#undef GRID_BAR
}

extern "C" void kernel_launch(void* const* d_in, const int* in_sizes, int n_in, void* d_out, int out_size, void* d_ws, size_t ws_size, hipStream_t stream) {
    static int grid = 0;
    if (grid == 0) {
        if (n_in != 25 || (size_t)out_size != O_END || ws_size < WS_END) { fprintf(stderr, "kernel_launch: unexpected sizes n_in %d out %d ws %zu\n", n_in, out_size, ws_size); grid = -1; return; }
        int dev = 0, cus = 0, per_cu = 0;
        if (hipGetDevice(&dev) != hipSuccess || hipDeviceGetAttribute(&cus, hipDeviceAttributeMultiprocessorCount, dev) != hipSuccess) { grid = -1; return; }
        if (hipFuncSetAttribute((const void*)mk_fwd, hipFuncAttributeMaxDynamicSharedMemorySize, LDS_BYTES) != hipSuccess) { fprintf(stderr, "kernel_launch: hipFuncSetAttribute failed\n"); grid = -1; return; }
        if (hipOccupancyMaxActiveBlocksPerMultiprocessor(&per_cu, (const void*)mk_fwd, NTHREADS, LDS_BYTES) != hipSuccess || per_cu < 1) { fprintf(stderr, "kernel_launch: occupancy query says %d\n", per_cu); (void)hipGetLastError(); per_cu = 1; }
        grid = cus;
    }
    if (grid < 0) return;
    Args a{};
    const float** f = (const float**)&a.xp;
    for (int i = 0; i < 25; ++i) f[i] = (const float*)d_in[i];
    a.out = (float*)d_out; a.ws = (unsigned char*)d_ws;
#if MK_MULTI
    for (int p = 0; p < N_PHASES; ++p) { a.ph_lo = p; a.ph_hi = p + 1; hipLaunchKernelGGL(mk_fwd, dim3(grid), dim3(NTHREADS), LDS_BYTES, stream, a); }
#else
    a.ph_lo = 0; a.ph_hi = N_PHASES;
    if (hipMemsetAsync((char*)d_ws + WS_CTL, 0, CTL_BYTES, stream) != hipSuccess) { fprintf(stderr, "kernel_launch: memset failed\n"); return; }
    hipLaunchKernelGGL(mk_fwd, dim3(grid), dim3(NTHREADS), LDS_BYTES, stream, a);
#endif
}
```

```cpp
#include <hip/hip_runtime.h>
#include <hip/hip_cooperative_groups.h>
#include <hip/hip_bf16.h>
#include <cstdio>
#include <cstdint>
namespace cg = cooperative_groups;

constexpr int DM = 1024, SEQ = 16384, NB = 2, MP = NB * SEQ  , SB = 16, SS = 32, MS = SB * SS  , MT = MP + MS  ;
constexpr int PAST = 1024, CBL = 512, NZ = 3072, DFF = 4096, DPLE = 256;
constexpr float LOG2E = 1.4426950408889634f, C2 = 0.125f * LOG2E;
constexpr size_t O_Y = 0, O_AKP = (size_t)MT * DM, O_AVP = O_AKP + (size_t)MP * 512, O_BKP = O_AVP + (size_t)MP * 512, O_BVP = O_BKP + (size_t)NB * 512 * 512,
                 O_AKS = O_BVP + (size_t)NB * 512 * 512, O_AVS = O_AKS + (size_t)MS * 512, O_BKS = O_AVS + (size_t)MS * 512, O_BVS = O_BKS + (size_t)MS * 512, O_END = O_BVS + (size_t)MS * 512;

namespace pg8 {
#define PG8_LAS __attribute__((address_space(3)))
typedef unsigned short bf16_t;
typedef short bf16x8 __attribute__((ext_vector_type(8)));
typedef float f32x4 __attribute__((ext_vector_type(4)));
typedef unsigned u32x4 __attribute__((ext_vector_type(4)));
constexpr int BM = 256, BK = 64, HALF = 128, HTB = HALF * BK * 2  , STAGE_BYTES = 8 * HTB, NXCD = 8, WGM = 8;

__host__ __device__ __forceinline__ int lds_byte(int r, int c) { const int st = (r >> 4) * 2 + (c >> 5), rr = r & 15, cc = c & 31, ob = rr * 64 + cc * 2; return st * 1024 + (ob ^ (((ob >> 9) & 1) << 5)); }
__host__ __device__ __forceinline__ void stage_rc(int b, int& R, int& C) { const int st = b / 1024, sb = b % 1024, swz = sb ^ (((sb >> 9) & 1) << 5); R = (st >> 1) * 16 + swz / 64; C = (st & 1) * 32 + (swz % 64) / 2; }
__host__ __device__ __forceinline__ int perm32(int rho) { const int n = rho >> 4, i = rho & 15; return 8 * (i >> 2) + 4 * n + (i & 3); }

struct Unit { int pm, pn; };
struct Gemm { const bf16_t* A; const bf16_t* Bt; int M, N, K; };

struct StaticOrder {
    int nM, nN, nwg, G, c;
    __host__ __device__ void init(int M, int N, int G_, int c_) { nM = M / BM; nN = N / BM; nwg = nM * nN; G = G_; c = c_; }
    __host__ __device__ bool next(int i, Unit& u) const {
        const long L = (long)i * G + c; if (L >= nwg) return false;
        int wgid = (int)L; { const int q = nwg / NXCD, r = nwg % NXCD, xcd = wgid % NXCD, off = wgid / NXCD; wgid = (xcd < r ? xcd * (q + 1) : r * (q + 1) + (xcd - r) * q) + off; }
        const int nig = WGM * nN, gid = wgid / nig, fm = gid * WGM, gsz = (nM - fm) < WGM ? (nM - fm) : WGM;
        u.pm = fm + ((wgid % nig) % gsz); u.pn = (wgid % nig) / gsz; return true;
    }
    __device__ __forceinline__ void a_ready(const Unit&) const {}
    __device__ __forceinline__ void done(const Unit&) const {}
};


typedef float f32x2 __attribute__((ext_vector_type(2)));
typedef __bf16 bf16x2_t __attribute__((ext_vector_type(2)));
__device__ __forceinline__ unsigned cvt_pk_bf16(float lo, float hi) { f32x2 v = {lo, hi}; bf16x2_t b = __builtin_convertvector(v, bf16x2_t); return __builtin_bit_cast(unsigned, b); }
__device__ __forceinline__ int lane_late() { int ln; asm volatile("v_mbcnt_lo_u32_b32 %0, -1, 0\n\tv_mbcnt_hi_u32_b32 %0, -1, %0" : "=v"(ln)); return ln; }
__device__ __forceinline__ u32x4 pack8(const f32x4& a, const f32x4& b) { u32x4 w; w.x = cvt_pk_bf16(a[0], a[1]); w.y = cvt_pk_bf16(a[2], a[3]); w.z = cvt_pk_bf16(b[0], b[1]); w.w = cvt_pk_bf16(b[2], b[3]); return w; }

struct EpiQKV {
    static constexpr bool PERM = true, AFTER_DRAIN = false;
    bf16_t* Z; float* out; int row_off;
    __device__ __forceinline__ void operator()(const f32x4 (&acc)[2][2][4][2], const Unit& u, int wr, int wc, int fr, int fq) const {
        { const int ln_ = lane_late(); fr = ln_ & 15; fq = ln_ >> 4; }
        const int seg = u.pn >> 1;
        const float sc = (seg == 0 || seg == 3) ? C2 : 1.0f;
        const int row0 = row_off + u.pm * BM + wr * 64 + fr, col0 = u.pn * BM + wc * 32 + 8 * fq, cs0 = col0 - seg * 512;
#pragma unroll
        for (int ai = 0; ai < 2; ++ai)
#pragma unroll
            for (int m = 0; m < 4; ++m) {
                const int row = row0 + ai * HALF + m * 16;
                bf16_t* zp = Z + (size_t)row * NZ + col0;
                float* fp = nullptr;
                if (seg == 1 || seg == 2 || seg == 4 || seg == 5) {
                    if (row < MP) {
                        if (seg == 1) fp = out + O_AKP + (size_t)row * 512;
                        else if (seg == 2) fp = out + O_AVP + (size_t)row * 512;
                        else { const int t = row & (SEQ - 1), b = row >> 14; if (t >= SEQ - 512) fp = out + (seg == 4 ? O_BKP : O_BVP) + (size_t)(b * 512 + t - (SEQ - 512)) * 512; }
                    } else {
                        const int rs = row - MP;
                        fp = out + (seg == 1 ? O_AKS : seg == 2 ? O_AVS : seg == 4 ? O_BKS : O_BVS) + (size_t)rs * 512;
                    }
                }
#pragma unroll
                for (int bj = 0; bj < 2; ++bj) {
                    const f32x4 v0 = acc[ai][bj][m][0], v1 = acc[ai][bj][m][1];
                    *(u32x4*)(zp + bj * HALF) = pack8(v0 * sc, v1 * sc);
                    if (fp) { *(f32x4*)(fp + cs0 + bj * HALF) = v0; *(f32x4*)(fp + cs0 + bj * HALF + 4) = v1; }
                }
            }
    }
};
struct EpiOut {
    static constexpr bool PERM = true, AFTER_DRAIN = false;
    const float* xp; const float* xs; float* Y; bf16_t* HB; float* SSQ; int row_off;
    __device__ __forceinline__ void operator()(const f32x4 (&acc)[2][2][4][2], const Unit& u, int wr, int wc, int fr, int fq) const {
        { const int ln_ = lane_late(); fr = ln_ & 15; fq = ln_ >> 4; }
        const int row0 = row_off + u.pm * BM + wr * 64 + fr, col0 = u.pn * BM + wc * 32 + 8 * fq;
#pragma unroll
        for (int ai = 0; ai < 2; ++ai)
#pragma unroll
            for (int m = 0; m < 4; ++m) {
                const int row = row0 + ai * HALF + m * 16;
                const float* xr = (row < MP ? xp + (size_t)row * DM : xs + (size_t)(row - MP) * DM) + col0;
                float ss = 0.f;
#pragma unroll
                for (int bj = 0; bj < 2; ++bj) {
                    const f32x4 h0 = *(const f32x4*)(xr + bj * HALF) + acc[ai][bj][m][0], h1 = *(const f32x4*)(xr + bj * HALF + 4) + acc[ai][bj][m][1];
                    float* yp = Y + (size_t)row * DM + col0 + bj * HALF; *(f32x4*)yp = h0; *(f32x4*)(yp + 4) = h1;
                    *(u32x4*)(HB + (size_t)row * DM + col0 + bj * HALF) = pack8(h0, h1);
                    ss += (h0[0] * h0[0] + h0[1] * h0[1]) + (h0[2] * h0[2] + h0[3] * h0[3]) + (h1[0] * h1[0] + h1[1] * h1[1]) + (h1[2] * h1[2] + h1[3] * h1[3]);
                }
                ss += __shfl_xor(ss, 16); ss += __shfl_xor(ss, 32);
                if (fq == 0) SSQ[(size_t)row * 16 + u.pn * 4 + wc] = ss;
            }
    }
};
struct EpiUp {
    static constexpr bool PERM = true, AFTER_DRAIN = false;
    bf16_t* U; const float* SSQ; int row_off;
    __device__ __forceinline__ void operator()(const f32x4 (&acc)[2][2][4][2], const Unit& u, int wr, int wc, int fr, int fq) const {
        { const int ln_ = lane_late(); fr = ln_ & 15; fq = ln_ >> 4; }
        const int row0 = row_off + u.pm * BM + wr * 64 + fr, col0 = u.pn * BM + wc * 32 + 8 * fq;
#pragma unroll
        for (int ai = 0; ai < 2; ++ai)
#pragma unroll
            for (int m = 0; m < 4; ++m) {
                const int row = row0 + ai * HALF + m * 16;
                const f32x4 s0 = ((const f32x4*)(SSQ + (size_t)row * 16))[fq];
                float tot = (s0[0] + s0[1]) + (s0[2] + s0[3]);
                tot += __shfl_xor(tot, 16); tot += __shfl_xor(tot, 32);
                const float rstd = 1.0f / sqrtf(tot * (1.0f / DM) + 1e-6f);
#pragma unroll
                for (int bj = 0; bj < 2; ++bj) {
                    f32x4 v0 = acc[ai][bj][m][0] * rstd, v1 = acc[ai][bj][m][1] * rstd;
#pragma unroll
                    for (int j = 0; j < 4; ++j) { const float a = fmaxf(v0[j], 0.f), b = fmaxf(v1[j], 0.f); v0[j] = a * a; v1[j] = b * b; }
                    *(u32x4*)(U + (size_t)row * DFF + col0 + bj * HALF) = pack8(v0, v1);
                }
            }
    }
};
struct EpiPP {
    static constexpr bool PERM = true, AFTER_DRAIN = false;
    bf16_t* PP; int row_off;
    __device__ __forceinline__ void operator()(const f32x4 (&acc)[2][2][4][2], const Unit& u, int wr, int wc, int fr, int fq) const {
        { const int ln_ = lane_late(); fr = ln_ & 15; fq = ln_ >> 4; }
        const int row0 = row_off + u.pm * BM + wr * 64 + fr, col0 = u.pn * BM + wc * 32 + 8 * fq;
#pragma unroll
        for (int ai = 0; ai < 2; ++ai)
#pragma unroll
            for (int m = 0; m < 4; ++m) {
                const int row = row0 + ai * HALF + m * 16;
#pragma unroll
                for (int bj = 0; bj < 2; ++bj) *(u32x4*)(PP + (size_t)row * DM + col0 + bj * HALF) = pack8(acc[ai][bj][m][0], acc[ai][bj][m][1]);
            }
    }
};
struct EpiDown {
    static constexpr bool PERM = true, AFTER_DRAIN = false;
    float* Y; bf16_t* HB; int row_off;
    __device__ __forceinline__ void operator()(const f32x4 (&acc)[2][2][4][2], const Unit& u, int wr, int wc, int fr, int fq) const {
        { const int ln_ = lane_late(); fr = ln_ & 15; fq = ln_ >> 4; }
        const int row0 = row_off + u.pm * BM + wr * 64 + fr, col0 = u.pn * BM + wc * 32 + 8 * fq;
#pragma unroll
        for (int ai = 0; ai < 2; ++ai)
#pragma unroll
            for (int m = 0; m < 4; ++m) {
                const int row = row0 + ai * HALF + m * 16;
#pragma unroll
                for (int bj = 0; bj < 2; ++bj) {
                    float* yp = Y + (size_t)row * DM + col0 + bj * HALF;
                    const f32x4 h0 = *(const f32x4*)yp + acc[ai][bj][m][0], h1 = *(const f32x4*)(yp + 4) + acc[ai][bj][m][1];
                    *(f32x4*)yp = h0; *(f32x4*)(yp + 4) = h1;
                    *(u32x4*)(HB + (size_t)row * DM + col0 + bj * HALF) = pack8(h0, h1);
                }
            }
    }
};
struct EpiGate {
    static constexpr bool PERM = true, AFTER_DRAIN = false;
    float* Y; const bf16_t* PP; float* SSQ; int row_off;
    __device__ __forceinline__ void operator()(const f32x4 (&acc)[2][2][4][2], const Unit& u, int wr, int wc, int fr, int fq) const {
        { const int ln_ = lane_late(); fr = ln_ & 15; fq = ln_ >> 4; }
        const int row0 = row_off + u.pm * BM + wr * 64 + fr, col0 = u.pn * BM + wc * 32 + 8 * fq;
#pragma unroll
        for (int ai = 0; ai < 2; ++ai)
#pragma unroll
            for (int m = 0; m < 4; ++m) {
                const int row = row0 + ai * HALF + m * 16;
                float ss = 0.f;
#pragma unroll
                for (int bj = 0; bj < 2; ++bj) {
                    float* yp = Y + (size_t)row * DM + col0 + bj * HALF;
                    const u32x4 pw = *(const u32x4*)(PP + (size_t)row * DM + col0 + bj * HALF);
                    f32x4 p0, p1;
                    p0[0] = __uint_as_float(pw.x << 16); p0[1] = __uint_as_float(pw.x & 0xffff0000u); p0[2] = __uint_as_float(pw.y << 16); p0[3] = __uint_as_float(pw.y & 0xffff0000u);
                    p1[0] = __uint_as_float(pw.z << 16); p1[1] = __uint_as_float(pw.z & 0xffff0000u); p1[2] = __uint_as_float(pw.w << 16); p1[3] = __uint_as_float(pw.w & 0xffff0000u);
                    f32x4 h0 = *(const f32x4*)yp, h1 = *(const f32x4*)(yp + 4);
                    const f32x4 a0 = acc[ai][bj][m][0], a1 = acc[ai][bj][m][1];
#pragma unroll
                    for (int j = 0; j < 4; ++j) {
                        const float g0 = __builtin_amdgcn_rcpf(1.0f + __builtin_amdgcn_exp2f(-LOG2E * a0[j])), g1 = __builtin_amdgcn_rcpf(1.0f + __builtin_amdgcn_exp2f(-LOG2E * a1[j]));
                        h0[j] += g0 * p0[j]; h1[j] += g1 * p1[j];
                    }
                    *(f32x4*)yp = h0; *(f32x4*)(yp + 4) = h1;
                    ss += (h0[0] * h0[0] + h0[1] * h0[1]) + (h0[2] * h0[2] + h0[3] * h0[3]) + (h1[0] * h1[0] + h1[1] * h1[1]) + (h1[2] * h1[2] + h1[3] * h1[3]);
                }
                ss += __shfl_xor(ss, 16); ss += __shfl_xor(ss, 32);
                if (fq == 0) SSQ[(size_t)row * 16 + u.pn * 4 + wc] = ss;
            }
    }
};

template <class Epi, class Sched, bool ALIGN_EPI = false, bool SP2 = false>
__device__ __forceinline__ void gemm_phase(PG8_LAS unsigned char* lds, const Gemm g, const Sched& S, const Epi& E, const int wave_s  ) {
    const int wid = wave_s, lane = lane_late(), tid = wid * 64 + lane, wr = wid >> 2, wc = wid & 3, fr = lane & 15, fq = lane >> 4;
    const int K = g.K, nt = K / BK;
    unsigned voffA[2], voffB[2];
#pragma unroll
    for (int i = 0; i < 2; ++i) { int R, C; stage_rc(tid * 16 + i * 8192, R, C); const int Rb = Epi::PERM ? ((R & ~31) + perm32(R & 31)) : R;
        voffA[i] = (unsigned)(R * K + C) * 2u; voffB[i] = (unsigned)(Rb * K + C) * 2u; }
    const size_t kstep = (size_t)(BK * 2);
    const size_t hstep = (size_t)HALF * K * 2;
    const size_t tstep = 2 * hstep;
    const unsigned ldsw = (unsigned)wid * 1024u;
    const int aoff = lds_byte(wr * 64 + fr, fq * 8), boff = lds_byte(wc * 32 + fr, fq * 8);
#define PG8_SA(b, h) (((b) * 2 + (h)) * HTB)
#define PG8_SB(b, h) ((4 + (b) * 2 + (h)) * HTB)
#define PG8_STAGE(bufoff, gbase, voff) do { _Pragma("unroll") for (int _i = 0; _i < 2; ++_i) \
        __builtin_amdgcn_global_load_lds((const unsigned*)((const char*)(gbase) + (voff)[_i]), (PG8_LAS unsigned*)(lds + (bufoff) + ldsw + _i * 8192), 16, 0, 0); } while (0)
#define PG8_LDA(dst, b, h) do { _Pragma("unroll") for (int m = 0; m < 4; ++m) _Pragma("unroll") for (int k = 0; k < 2; ++k) dst[m][k] = *(const PG8_LAS bf16x8*)(lds + PG8_SA(b, h) + aoff + m * 2048 + k * 1024); } while (0)
#define PG8_LDB(dst, b, h) do { _Pragma("unroll") for (int n = 0; n < 2; ++n) _Pragma("unroll") for (int k = 0; k < 2; ++k) dst[n][k] = *(const PG8_LAS bf16x8*)(lds + PG8_SB(b, h) + boff + n * 2048 + k * 1024); } while (0)
#define PG8_MMA(ai, bj, At, Bt) do { __builtin_amdgcn_s_setprio(1); _Pragma("unroll") for (int m = 0; m < 4; ++m) _Pragma("unroll") for (int n = 0; n < 2; ++n) _Pragma("unroll") for (int k = 0; k < 2; ++k) \
        acc[ai][bj][m][n] = __builtin_amdgcn_mfma_f32_16x16x32_bf16(Bt[n][k], At[m][k], acc[ai][bj][m][n], 0, 0, 0); __builtin_amdgcn_s_setprio(0); } while (0)
#define PG8_WAIT_V(n) asm volatile("s_waitcnt vmcnt(" #n ")" ::: "memory")
#define PG8_WAIT_L(n) asm volatile("s_waitcnt lgkmcnt(" #n ")" ::: "memory")
#define PG8_BAR __builtin_amdgcn_s_barrier()
#define PG8_SCHED __builtin_amdgcn_sched_barrier(0)
    Unit cur, nxt; int ui = 0;
    if (!S.next(0, cur)) return;
    f32x4 acc[2][2][4][2];
#pragma unroll
    for (int a = 0; a < 2; ++a)
#pragma unroll
        for (int b = 0; b < 2; ++b)
#pragma unroll
            for (int m = 0; m < 4; ++m)
#pragma unroll
                for (int n = 0; n < 2; ++n) acc[a][b][m][n] = (f32x4){0.f, 0.f, 0.f, 0.f};
    bf16x8 At[4][2], B0[2][2], B1[2][2];
    const char* cA = (const char*)g.A + (size_t)cur.pm * tstep; const char* cB = (const char*)g.Bt + (size_t)cur.pn * tstep;
    S.a_ready(cur);
    if constexpr (SP2) {
        PG8_STAGE(PG8_SB(0, 0), cB, voffB); PG8_STAGE(PG8_SB(0, 1), cB + hstep, voffB); PG8_STAGE(PG8_SA(0, 0), cA, voffA); PG8_STAGE(PG8_SA(0, 1), cA + hstep, voffA);
        if (wr == 1) PG8_BAR;
        PG8_WAIT_V(2); PG8_BAR;
        PG8_STAGE(PG8_SB(1, 0), cB + kstep, voffB); PG8_STAGE(PG8_SA(1, 0), cA + kstep, voffA); PG8_STAGE(PG8_SB(1, 1), cB + hstep + kstep, voffB);
        PG8_WAIT_V(6); PG8_BAR;
    } else {
        PG8_STAGE(PG8_SB(0, 0), cB, voffB); PG8_STAGE(PG8_SA(0, 0), cA, voffA); PG8_STAGE(PG8_SB(0, 1), cB + hstep, voffB); PG8_STAGE(PG8_SA(0, 1), cA + hstep, voffA);
        if (wr == 1) PG8_BAR;
        PG8_WAIT_V(4); PG8_BAR;
        PG8_STAGE(PG8_SB(1, 0), cB + kstep, voffB); PG8_STAGE(PG8_SA(1, 0), cA + kstep, voffA); PG8_STAGE(PG8_SB(1, 1), cB + hstep + kstep, voffB);
        PG8_WAIT_V(6); PG8_BAR;
    }
    for (;;) {
        const bool has_next = S.next(ui + 1, nxt);
        const char* nA = has_next ? (const char*)g.A + (size_t)nxt.pm * tstep : cA; const char* nB = has_next ? (const char*)g.Bt + (size_t)nxt.pn * tstep : cB;
        for (int t = 0; t < nt; t += 2) {
            const bool last = (t == nt - 2);
            const char* a1 = cA + (size_t)(t + 1) * kstep;
            const char* a2 = last ? nA : cA + (size_t)(t + 2) * kstep; const char* b2 = last ? nB : cB + (size_t)(t + 2) * kstep;
            const char* a3 = a2 + kstep; const char* b3 = b2 + kstep;
            if (last && has_next) S.a_ready(nxt);
            if constexpr (SP2) {
            PG8_LDB(B0, 0, 0); PG8_LDB(B1, 0, 1); PG8_SCHED; PG8_LDA(At, 0, 0); PG8_STAGE(PG8_SA(1, 1), a1 + hstep, voffA);
            PG8_WAIT_V(8); PG8_WAIT_L(0); PG8_BAR; PG8_MMA(0, 0, At, B0); PG8_MMA(0, 1, At, B1); PG8_BAR; PG8_SCHED;
            PG8_LDA(At, 0, 1); PG8_STAGE(PG8_SB(0, 0), b2, voffB); PG8_STAGE(PG8_SB(0, 1), b2 + hstep, voffB); PG8_STAGE(PG8_SA(0, 0), a2, voffA);
            PG8_WAIT_V(8); PG8_WAIT_L(0); PG8_BAR; PG8_MMA(1, 0, At, B0); PG8_MMA(1, 1, At, B1); PG8_BAR; PG8_SCHED;
            PG8_LDB(B0, 1, 0); PG8_LDB(B1, 1, 1); PG8_SCHED; PG8_LDA(At, 1, 0); PG8_STAGE(PG8_SA(0, 1), a2 + hstep, voffA);
            PG8_WAIT_V(8); PG8_WAIT_L(0); PG8_BAR; PG8_MMA(0, 0, At, B0); PG8_MMA(0, 1, At, B1); PG8_BAR; PG8_SCHED;
            PG8_LDA(At, 1, 1); PG8_STAGE(PG8_SB(1, 0), b3, voffB); PG8_STAGE(PG8_SB(1, 1), b3 + hstep, voffB); PG8_STAGE(PG8_SA(1, 0), a3, voffA);
            PG8_WAIT_V(8); PG8_WAIT_L(0); PG8_BAR; PG8_MMA(1, 0, At, B0); PG8_MMA(1, 1, At, B1); PG8_BAR; PG8_SCHED;
            } else {
            PG8_LDB(B0, 0, 0); PG8_SCHED; PG8_LDA(At, 0, 0); PG8_STAGE(PG8_SA(1, 1), a1 + hstep, voffA);
            PG8_WAIT_L(8); PG8_BAR; PG8_WAIT_L(0); PG8_MMA(0, 0, At, B0); PG8_BAR; PG8_SCHED;
            PG8_LDB(B1, 0, 1); PG8_STAGE(PG8_SB(0, 0), b2, voffB);
            PG8_BAR; PG8_WAIT_L(0); PG8_MMA(0, 1, At, B1); PG8_BAR;
            PG8_LDA(At, 0, 1); PG8_STAGE(PG8_SA(0, 0), a2, voffA);
            PG8_BAR; PG8_WAIT_L(0); PG8_MMA(1, 0, At, B0); PG8_BAR; PG8_SCHED;
            PG8_STAGE(PG8_SB(0, 1), b2 + hstep, voffB);
            PG8_WAIT_V(6); PG8_BAR; PG8_MMA(1, 1, At, B1); PG8_BAR;
            PG8_LDB(B0, 1, 0); PG8_SCHED; PG8_LDA(At, 1, 0); PG8_STAGE(PG8_SA(0, 1), a2 + hstep, voffA);
            PG8_WAIT_L(8); PG8_BAR; PG8_WAIT_L(0); PG8_MMA(0, 0, At, B0); PG8_BAR; PG8_SCHED;
            PG8_LDB(B1, 1, 1); PG8_STAGE(PG8_SB(1, 0), b3, voffB);
            PG8_BAR; PG8_WAIT_L(0); PG8_MMA(0, 1, At, B1); PG8_BAR;
            PG8_LDA(At, 1, 1); PG8_STAGE(PG8_SA(1, 0), a3, voffA);
            PG8_BAR; PG8_WAIT_L(0); PG8_MMA(1, 0, At, B0); PG8_BAR; PG8_SCHED;
            PG8_STAGE(PG8_SB(1, 1), b3 + hstep, voffB);
            PG8_WAIT_V(6); PG8_BAR; PG8_MMA(1, 1, At, B1); PG8_BAR;
            }
        }
        if constexpr (ALIGN_EPI) { if (wr == 0) PG8_BAR; }
        if constexpr (!Epi::AFTER_DRAIN) { E(acc, cur, wr, wc, fr, fq); S.done(cur); }
        if (!has_next) break;
#pragma unroll
        for (int a = 0; a < 2; ++a)
#pragma unroll
            for (int b = 0; b < 2; ++b)
#pragma unroll
                for (int m = 0; m < 4; ++m)
#pragma unroll
                    for (int n = 0; n < 2; ++n) acc[a][b][m][n] = (f32x4){0.f, 0.f, 0.f, 0.f};
        cur = nxt; cA = nA; cB = nB; ++ui;
        if constexpr (ALIGN_EPI) { if (wr == 1) PG8_BAR; }
    }
    PG8_WAIT_V(0);
    if constexpr (!ALIGN_EPI) { if (wr == 0) PG8_BAR; }
    PG8_BAR;
    if constexpr (Epi::AFTER_DRAIN) { E.fused(acc, cur, wr, wc, fr, fq, lds, wid, lane); S.done(cur); }
#undef PG8_SA
#undef PG8_SB
#undef PG8_STAGE
#undef PG8_LDA
#undef PG8_LDB
#undef PG8_MMA
#undef PG8_WAIT_V
#undef PG8_WAIT_L
#undef PG8_BAR
#undef PG8_SCHED
}
}

namespace att {
#define LAS __attribute__((address_space(3)))
typedef unsigned short bf16_t;
typedef short bf16x8 __attribute__((ext_vector_type(8)));
typedef short s16x4 __attribute__((ext_vector_type(4)));
typedef short v4i16_t __attribute__((ext_vector_type(4)));
typedef float f32x16 __attribute__((ext_vector_type(16)));
typedef float f32x4 __attribute__((ext_vector_type(4)));
typedef unsigned u32x4 __attribute__((ext_vector_type(4)));
typedef LAS unsigned char* ldsp;
typedef const LAS unsigned char* ldscp;
constexpr float THR = 8.0f;
constexpr float NEGBIG = -1.0e30f;
constexpr int L_T5 = 131072;
constexpr int L_BT = L_T5 + 8192;
constexpr int L_WSF = L_BT + 8448;
constexpr int L_XCH = L_WSF + 2048;
constexpr int L_END = L_XCH + 2048;

__device__ __forceinline__ int crow(int r, int hi) { return (r & 3) + 8 * (r >> 2) + 4 * hi; }
__device__ __forceinline__ constexpr int crow0(int r) { return (r & 3) + 8 * (r >> 2); }
__device__ __forceinline__ unsigned cvtpk(float lo, float hi) { return pg8::cvt_pk_bf16(lo, hi); }
__device__ __forceinline__ s16x4 vtr(ldscp p) { return __builtin_bit_cast(s16x4, __builtin_amdgcn_ds_read_tr16_b64_v4i16((LAS v4i16_t*)p)); }
__device__ __forceinline__ float hmax32(float m) { return fmaxf(m, __shfl_xor(m, 32)); }
__device__ __forceinline__ u32x4 cvt8(const f32x4& a, const f32x4& b) { return pg8::pack8(a, b); }
__device__ __forceinline__ int t5_bucket(int rel) {
    int n = -rel; const int ret = n < 0 ? 16 : 0; n = n < 0 ? -n : n;
    if (n < 8) return ret + n;
    return ret + 8 + (n >= 12) + (n >= 16) + (n >= 23) + (n >= 32) + (n >= 46) + (n >= 64) + (n >= 91);
}

__device__ __forceinline__ void qkt(f32x16& p0, f32x16& p1, ldscp Kslot, const bf16x8* qr, const f32x16& cinit, int r32, int hi) {
    ldscp kb = Kslot + hi * 1024 + r32 * 16;
#pragma unroll
    for (int d0 = 0; d0 < 4; ++d0) {
        const bf16x8 b0 = *(const LAS bf16x8*)(kb + d0 * 2048);
        const bf16x8 b1 = *(const LAS bf16x8*)(kb + d0 * 2048 + 512);
        if (d0 == 0) { p0 = __builtin_amdgcn_mfma_f32_32x32x16_bf16(b0, qr[0], cinit, 0, 0, 0); p1 = __builtin_amdgcn_mfma_f32_32x32x16_bf16(b1, qr[0], cinit, 0, 0, 0); }
        else { p0 = __builtin_amdgcn_mfma_f32_32x32x16_bf16(b0, qr[d0], p0, 0, 0, 0); p1 = __builtin_amdgcn_mfma_f32_32x32x16_bf16(b1, qr[d0], p1, 0, 0, 0); }
    }
}
template <int NDB> __device__ __forceinline__ void softmax_step(f32x16& p0, f32x16& p1, float& mhat, float& l, f32x16* o, LAS float* wsf, int r32, int hi, float bc) {
    float a = fmaxf(p0[0], p1[0]);
#pragma unroll
    for (int r = 1; r < 16; ++r) a = fmaxf(a, fmaxf(p0[r], p1[r]));
    const float rm = hmax32(a) + bc;
    if (__any(rm > mhat + THR)) {
        const float mn = fmaxf(mhat, rm), f = __builtin_amdgcn_exp2f(mhat - mn);
        l *= f; mhat = mn;
        if (hi == 0) wsf[r32] = f;
        float fr[16]; const LAS float* wq = wsf + 4 * hi;
#pragma unroll
        for (int r = 0; r < 16; ++r) fr[r] = wq[crow0(r)];
#pragma unroll
        for (int d = 0; d < NDB; ++d)
#pragma unroll
            for (int r = 0; r < 16; ++r) o[d][r] *= fr[r];
    }
    float s = 0.f; const float mref = mhat - bc;
#pragma unroll
    for (int r = 0; r < 16; ++r) { p0[r] = __builtin_amdgcn_exp2f(p0[r] - mref); p1[r] = __builtin_amdgcn_exp2f(p1[r] - mref); s += p0[r] + p1[r]; }
    l += s;
}
__device__ __forceinline__ void packp(u32x4* pw, const f32x16& p0, const f32x16& p1) {
    pw[0] = (u32x4){cvtpk(p0[0], p0[1]), cvtpk(p0[2], p0[3]), cvtpk(p0[4], p0[5]), cvtpk(p0[6], p0[7])};
    pw[1] = (u32x4){cvtpk(p0[8], p0[9]), cvtpk(p0[10], p0[11]), cvtpk(p0[12], p0[13]), cvtpk(p0[14], p0[15])};
    pw[2] = (u32x4){cvtpk(p1[0], p1[1]), cvtpk(p1[2], p1[3]), cvtpk(p1[4], p1[5]), cvtpk(p1[6], p1[7])};
    pw[3] = (u32x4){cvtpk(p1[8], p1[9]), cvtpk(p1[10], p1[11]), cvtpk(p1[12], p1[13]), cvtpk(p1[14], p1[15])};
}
__device__ __forceinline__ bf16x8 vfrag(ldscp vp, int db, int ks) {
    const s16x4 lo = vtr(vp + db * 4096 + ks * 1024), hi = vtr(vp + db * 4096 + ks * 1024 + 512);
    return (bf16x8){lo[0], lo[1], lo[2], lo[3], hi[0], hi[1], hi[2], hi[3]};
}
__device__ __forceinline__ int vlane_off(int lane) { const int hi = lane >> 5; return ((lane >> 4) & 1) * 32 + (lane & 3) * 8 + (4 * hi + ((lane & 15) >> 2)) * 64; }

struct Ctx {
    const bf16_t* Z; bf16_t* AO;
    const float *cak, *cav, *cbk, *cbv;
    const float *subln_g, *onb;
    float lam;
    LAS unsigned char* lds;
    int tid, lane, wid, r32, hi;
};

struct DiffState { float m, l; f32x16 o[4]; bf16x8 q[4]; };

template <bool NEAR> __device__ __forceinline__ void diff_tile(DiffState& S, const Ctx& c, ldscp slot, float bfar, int h, int relb, bool half) {
    LAS float* wsf = (LAS float*)(c.lds + L_WSF) + c.wid * 64;
    const LAS float* t5 = (const LAS float*)(c.lds + L_T5) + h * 512;
    const f32x16 zero = f32x16{};
    f32x16 p0, p1; u32x4 pw[4];
    qkt(p0, p1, slot + (c.wid >> 2) * 8192, S.q, zero, c.r32, c.hi);
    if (NEAR) {
        const LAS float* tb = t5 + (relb + 4 * c.hi);
#pragma unroll
        for (int r = 0; r < 16; ++r) { p0[r] += tb[crow0(r)]; p1[r] += tb[crow0(r) + 32]; }
    }
    if (half) {
#pragma unroll
        for (int r = 0; r < 16; ++r) p1[r] = NEGBIG;
    }
    softmax_step<4>(p0, p1, S.m, S.l, S.o, wsf, c.r32, c.hi, NEAR ? 0.f : bfar);
    packp(pw, p0, p1);
    ldscp vp = slot + 16384 + vlane_off(c.lane);
    __builtin_amdgcn_sched_barrier(0);
#pragma unroll
    for (int db = 0; db < 4; ++db) {
#pragma unroll
        for (int ks = 0; ks < 4; ++ks) {
            const bf16x8 vf = vfrag(vp, db, ks);
            S.o[db] = __builtin_amdgcn_mfma_f32_32x32x16_bf16(__builtin_bit_cast(bf16x8, pw[ks]), vf, S.o[db], 0, 0, 0);
        }
        __builtin_amdgcn_sched_barrier(0);
    }
}
__device__ __forceinline__ void diff_init(DiffState& S, const Ctx& c, const bf16_t* qrow  ) {
    S.m = NEGBIG; S.l = 0.f;
#pragma unroll
    for (int d = 0; d < 4; ++d) S.o[d] = f32x16{};
#pragma unroll
    for (int d0 = 0; d0 < 4; ++d0) S.q[d0] = *(const bf16x8*)(qrow + d0 * 16 + c.hi * 8);
}
__device__ __forceinline__ void diff_finish(DiffState& S, const Ctx& c, int h, size_t orow0, bool active) {
    LAS float* wsf = (LAS float*)(c.lds + L_WSF) + c.wid * 64;
    LAS float* xo = (LAS float*)c.lds + (c.wid & 3) * 4096;
    const float lt = S.l + __shfl_xor(S.l, 32);
    if (c.wid >= 4) {
        if (c.hi == 0) wsf[c.r32] = c.lam / lt;
        float sc[16]; const LAS float* wq = wsf + 4 * c.hi;
#pragma unroll
        for (int r = 0; r < 16; ++r) sc[r] = wq[crow0(r)];
        if (active) {
#pragma unroll
            for (int db = 0; db < 4; ++db)
#pragma unroll
                for (int r = 0; r < 16; ++r) xo[(db * 16 + r) * 64 + c.lane] = S.o[db][r] * sc[r];
        }
    }
    __syncthreads();
    if (c.wid < 4 && active) {
        if (c.hi == 0) wsf[c.r32] = 1.0f / lt;
        float g[4];
#pragma unroll
        for (int db = 0; db < 4; ++db) g[db] = c.subln_g[db * 32 + c.r32] * 0.8f;
        const LAS float* wq = wsf + 4 * c.hi;
        bf16_t* ob = c.AO + (orow0 + 4 * c.hi) * DM + h * 128 + c.r32;
#pragma unroll
        for (int r = 0; r < 16; ++r) {
            const float a = wq[crow0(r)];
            float v[4], ss = 0.f;
#pragma unroll
            for (int db = 0; db < 4; ++db) { v[db] = S.o[db][r] * a - xo[(db * 16 + r) * 64 + c.lane]; ss += v[db] * v[db]; }
            ss += __shfl_xor(ss, 1); ss += __shfl_xor(ss, 2); ss += __shfl_xor(ss, 4); ss += __shfl_xor(ss, 8); ss += __shfl_xor(ss, 16);
            const float rs = 1.0f / sqrtf(ss * (1.0f / 128.0f) + 1e-5f);
            bf16_t* op = ob + crow0(r) * DM;
#pragma unroll
            for (int db = 0; db < 4; ++db) op[db * 32] = (bf16_t)(cvtpk(v[db] * rs * g[db], 0.f) & 0xffffu);
        }
    }
    __syncthreads();
}
__device__ __forceinline__ void diff_prompt_unit(const Ctx& c0, int b, int h, int qb) {
    Ctx c = c0; c.lane = pg8::lane_late(); c.tid = c.wid * 64 + c.lane; c.r32 = c.lane & 31; c.hi = c.lane >> 5;
    const int q0 = qb * 128, NT = qb * 2 + 2, wq = c.wid & 3, tlast = qb * 2 + (wq >> 1);
    const size_t rowb = (size_t)b * SEQ;
    const size_t qrow = rowb + q0 + wq * 32 + c.r32;
    DiffState S; diff_init(S, c, c.Z + qrow * NZ + h * 128 + (c.wid >> 2) * 64);
    const float cfar = ((const LAS float*)(c.lds + L_T5))[h * 512 + 448 - 100];
    const bf16_t* k1src = c.Z + (rowb + c.lane) * NZ + 512 + h * 128 + c.wid * 8;
    const bf16_t* vsrc0 = c.Z + (rowb + 16 * (c.wid & 3) + (c.lane >> 2)) * NZ + 1024 + h * 128 + (c.wid >> 2) * 32 + (c.lane & 3) * 8;
    const int wofs = c.wid * 1024 + c.lane * 16;
    u32x4 r0, r1, r2, r3;
#define DP_LOAD(t) do { const size_t o_ = (size_t)(t) * 64 * NZ; r0 = *(const u32x4*)(k1src + o_); r1 = *(const u32x4*)(k1src + o_ + 64); r2 = *(const u32x4*)(vsrc0 + o_); r3 = *(const u32x4*)(vsrc0 + o_ + 64); } while (0)
#define DP_WRITE(buf) do { ldsp s_ = c.lds + (buf) * 32768; *(LAS u32x4*)(s_ + wofs) = r0; *(LAS u32x4*)(s_ + 8192 + wofs) = r1; *(LAS u32x4*)(s_ + 16384 + wofs) = r2; *(LAS u32x4*)(s_ + 16384 + 8192 + wofs) = r3; } while (0)
    DP_LOAD(0); DP_WRITE(0); __syncthreads();
    for (int t = 0; t < NT; ++t) {
        if (t + 1 < NT) DP_LOAD(t + 1);
        if (t <= tlast) {
            ldscp slot = c.lds + (t & 1) * 32768;
            if (t >= qb * 2 - 2) diff_tile<true>(S, c, slot, cfar, h, 64 * t - (q0 + wq * 32 + c.r32) + 448, false);
            else diff_tile<false>(S, c, slot, cfar, h, 0, false);
        }
        if (t + 1 < NT) DP_WRITE((t + 1) & 1);
        __syncthreads();
    }
#undef DP_LOAD
#undef DP_WRITE
    diff_finish(S, c, h, rowb + q0 + wq * 32, true);
}
__device__ __forceinline__ void diff_sample_unit(const Ctx& c0, int b, int h) {
    Ctx c = c0; c.lane = pg8::lane_late(); c.tid = c.wid * 64 + c.lane; c.r32 = c.lane & 31; c.hi = c.lane >> 5;
    const size_t qrow = (size_t)MP + b * SS + c.r32;
    DiffState S; diff_init(S, c, c.Z + qrow * NZ + h * 128 + (c.wid >> 2) * 64);
    const float cfar = ((const LAS float*)(c.lds + L_T5))[h * 512 + 448 - 100];
    const int wofs = c.wid * 1024 + c.lane * 16;
    const bool active = (c.wid & 3) == 0;
    for (int t = 0; t <= 16; ++t) {
        u32x4 r0, r1, r2, r3;
        if (t < 16) {
            const float* ks = c.cak + (((size_t)(b * PAST + 64 * t + c.lane) * 4 + h) * 2) * 64 + c.wid * 8;
            r0 = cvt8(*(const f32x4*)ks, *(const f32x4*)(ks + 4)); r1 = cvt8(*(const f32x4*)(ks + 64), *(const f32x4*)(ks + 68));
            __builtin_amdgcn_sched_barrier(0);
            const float* vs = c.cav + ((size_t)(b * PAST + 64 * t + 16 * (c.wid & 3) + (c.lane >> 2)) * 4 + h) * 128 + (c.wid >> 2) * 32 + (c.lane & 3) * 8;
            r2 = cvt8(*(const f32x4*)vs, *(const f32x4*)(vs + 4)); r3 = cvt8(*(const f32x4*)(vs + 64), *(const f32x4*)(vs + 68));
        } else {
            const u32x4 z4 = (u32x4){0u, 0u, 0u, 0u};
            r0 = z4; r1 = z4; r2 = z4; r3 = z4;
            if (c.lane < 32) { const bf16_t* ks = c.Z + ((size_t)MP + b * SS + c.lane) * NZ + 512 + h * 128 + c.wid * 8; r0 = *(const u32x4*)ks; r1 = *(const u32x4*)(ks + 64); }
            const int vk = 16 * (c.wid & 3) + (c.lane >> 2);
            if (vk < 32) { const bf16_t* vs = c.Z + ((size_t)MP + b * SS + vk) * NZ + 1024 + h * 128 + (c.wid >> 2) * 32 + (c.lane & 3) * 8; r2 = *(const u32x4*)vs; r3 = *(const u32x4*)(vs + 64); }
        }
        ldsp s_ = c.lds;
        *(LAS u32x4*)(s_ + wofs) = r0; *(LAS u32x4*)(s_ + 8192 + wofs) = r1; *(LAS u32x4*)(s_ + 16384 + wofs) = r2; *(LAS u32x4*)(s_ + 16384 + 8192 + wofs) = r3;
        __builtin_amdgcn_sched_barrier(0);
        __syncthreads();
        if (active) {
            const int relb = 64 * t - (PAST + c.r32) + 448;
            if (t >= 14) diff_tile<true>(S, c, c.lds, cfar, h, relb, t == 16);
            else diff_tile<false>(S, c, c.lds, cfar, h, 0, false);
        }
        __syncthreads();
    }
    diff_finish(S, c, h, (size_t)MP + b * SS, active);
}


#define SBAR() __builtin_amdgcn_sched_barrier(0)
#define PIN(x) asm volatile("" : "+v"(x))
#define WAIT_BAR(N) asm volatile("s_waitcnt vmcnt(" #N ") lgkmcnt(0)\n\ts_barrier" ::: "memory")
__device__ __forceinline__ void glds16(const void* gsrc, unsigned lds_dst) { unsigned keep;
    asm volatile("s_mov_b32 %0, m0\n\ts_mov_b32 m0, %2\n\ts_nop 0\n\tglobal_load_lds_dwordx4 %1, off\n\ts_mov_b32 m0, %0" : "=&s"(keep) : "v"(gsrc), "s"(lds_dst) : "memory"); }
__device__ __forceinline__ void kload8(bf16x8* kf, ldscp kp) {
    kf[0] = *(const LAS bf16x8*)(kp);        kf[1] = *(const LAS bf16x8*)(kp + 512);
    kf[2] = *(const LAS bf16x8*)(kp + 2048); kf[3] = *(const LAS bf16x8*)(kp + 2560);
    kf[4] = *(const LAS bf16x8*)(kp + 4096); kf[5] = *(const LAS bf16x8*)(kp + 4608);
    kf[6] = *(const LAS bf16x8*)(kp + 6144); kf[7] = *(const LAS bf16x8*)(kp + 6656);
}
__device__ __forceinline__ void kload2(bf16x8* kf, ldscp kp, int j) { kf[2 * j] = *(const LAS bf16x8*)(kp + j * 2048); kf[2 * j + 1] = *(const LAS bf16x8*)(kp + j * 2048 + 512); }

__device__ __forceinline__ void diff_prompt_unit2(const Ctx& c0, int b, int h, int qb) {
    Ctx c = c0; c.lane = pg8::lane_late(); c.tid = c.wid * 64 + c.lane; c.r32 = c.lane & 31; c.hi = c.lane >> 5;
    const int wq = c.wid & 3, map = c.wid >> 2, r32 = c.r32, hi = c.hi;
    const int q0 = qb * 128, NT = qb * 2 + 2, qchunk = NT - 2 + (wq >> 1);
    const size_t rowb = (size_t)b * SEQ;
    LAS float* wsf = (LAS float*)(c.lds + L_WSF) + c.wid * 64;
    const LAS float* t5 = (const LAS float*)(c.lds + L_T5) + h * 512;
    const float bfar = t5[448 - 100];
    const bf16_t* ksrc = c.Z + (rowb + c.lane) * NZ + 512 + h * 128 + c.wid * 8;
    const bf16_t* vsrc = c.Z + (rowb + 16 * (c.wid & 3) + (c.lane >> 2)) * NZ + 1024 + h * 128 + (c.wid >> 2) * 32 + (c.lane & 3) * 8;
    const unsigned lds0 = (unsigned)(uintptr_t)c.lds;
    const unsigned kdst = lds0 + c.wid * 1024, vdst = lds0 + 49152 + c.wid * 1024;
#define TCL(t) ((t) < NT ? (t) : NT - 1)
#define DMA_K(t, s) do { const size_t o_ = (size_t)TCL(t) * 64 * NZ; glds16(ksrc + o_, (unsigned)__builtin_amdgcn_readfirstlane(kdst + (s) * 8192)); glds16(ksrc + o_ + 64, (unsigned)__builtin_amdgcn_readfirstlane(kdst + 24576 + (s) * 8192)); } while (0)
#define DMA_V(t, s) do { const size_t o_ = (size_t)TCL(t) * 64 * NZ; glds16(vsrc + o_, (unsigned)__builtin_amdgcn_readfirstlane(vdst + (s) * 16384)); glds16(vsrc + o_ + 64, (unsigned)__builtin_amdgcn_readfirstlane(vdst + 8192 + (s) * 16384)); } while (0)
    ldscp kp0 = (ldscp)c.lds + map * 24576 + hi * 1024 + r32 * 16;
    ldscp vp0 = (ldscp)c.lds + 49152 + vlane_off(c.lane);
    DMA_K(0, 0); DMA_V(0, 0); DMA_K(1, 1);
    bf16x8 qf[4];
    { const bf16_t* qrow = c.Z + (rowb + q0 + wq * 32 + r32) * NZ + h * 128 + map * 64;
#pragma unroll
      for (int d0 = 0; d0 < 4; ++d0) qf[d0] = *(const bf16x8*)(qrow + d0 * 16 + hi * 8); }
    float mhat = NEGBIG, l_reg = 0.f; f32x16 o[4]; o[0] = f32x16{}; o[1] = f32x16{}; o[2] = f32x16{}; o[3] = f32x16{};
    const f32x16 zero = f32x16{};
    bool resc = false;
    const int relq = -(q0 + wq * 32 + r32) + 448 + 4 * hi;
    bf16x8 kf[8];
    f32x16 pA0, pA1, pB0, pB1;
    int sp = 0, sc = 0, sn = 1;
#define ROT() do { sp = sc; sc = sn; sn = (sn == 2) ? 0 : sn + 1; } while (0)
#define NEARFIX(C0, C1, t) do { if ((t) >= NT - 4) { const LAS float* tb_ = t5 + (relq + 64 * (t)); const float madd_ = (t) > qchunk ? NEGBIG : 0.f; \
        _Pragma("unroll") for (int r = 0; r < 16; ++r) { C0[r] += tb_[crow0(r)] + madd_; C1[r] += tb_[crow0(r) + 32] + madd_; } } } while (0)
#define MX3(a, b, c) __builtin_fmaxf(__builtin_fmaxf((a), (b)), (c))
#define DECIDE(C0, C1, bc, msub) do { \
        float a_ = MX3(C0[0], C0[1], C1[0]), b_ = MX3(C0[2], C0[3], C1[1]); a_ = MX3(a_, C1[2], C1[3]); \
        _Pragma("unroll") for (int r = 4; r < 16; r += 4) { a_ = MX3(a_, C0[r], C0[r + 1]); b_ = MX3(b_, C0[r + 2], C0[r + 3]); a_ = MX3(a_, C1[r], C1[r + 1]); b_ = MX3(b_, C1[r + 2], C1[r + 3]); } \
        float rm_ = __builtin_fmaxf(a_, b_); { auto rr_ = __builtin_amdgcn_permlane32_swap(__float_as_uint(rm_), __float_as_uint(rm_), false, false); rm_ = __builtin_fmaxf(__uint_as_float(rr_[0]), __uint_as_float(rr_[1])); } \
        rm_ += (bc); resc = false; \
        if (__builtin_expect(__any(rm_ > mhat + THR), 0)) { const float mn_ = __builtin_fmaxf(mhat, rm_); const float f_ = __builtin_amdgcn_exp2f(mhat - mn_); mhat = mn_; l_reg *= f_; if (hi == 0) wsf[r32] = f_; resc = true; } \
        msub = mhat - (bc); } while (0)
#define RESC() do { if (resc) { asm volatile("s_waitcnt lgkmcnt(0)" ::: "memory"); const LAS float* wq_ = wsf + 4 * hi; \
        _Pragma("unroll") for (int d_ = 0; d_ < 4; ++d_) _Pragma("unroll") for (int r = 0; r < 16; ++r) o[d_][r] *= wq_[crow0(r)]; } } while (0)
    DMA_K(2, 2);
    WAIT_BAR(6);
    qkt(pA0, pA1, (ldscp)c.lds + map * 24576, qf, zero, r32, hi);
    NEARFIX(pA0, pA1, 0);
    { float msub; const float bc0 = (0 >= NT - 4) ? 0.f : bfar; DECIDE(pA0, pA1, bc0, msub); resc = false;
#pragma unroll
      for (int r = 0; r < 16; ++r) { pA0[r] = __builtin_amdgcn_exp2f(pA0[r] - msub); pA1[r] = __builtin_amdgcn_exp2f(pA1[r] - msub); } }
    WAIT_BAR(0);
    DMA_K(3, 0); DMA_V(1, 1);
    ROT();
    kload8(kf, kp0 + sc * 8192);
    WAIT_BAR(4);
    s16x4 vlo[8], vhi[8]; u32x4 pw0, pw1, pw2, pw3;
#define PKW(P, B) cvtpk(P[B], P[B + 1])
#define PAF(k) __builtin_bit_cast(bf16x8, pw##k)
#define VFR(i) (bf16x8){vlo[i][0], vlo[i][1], vlo[i][2], vlo[i][3], vhi[i][0], vhi[i][1], vhi[i][2], vhi[i][3]}
#define VRD(i, f) do { vlo[i] = vtr(vp_ + (((f) & 3) * 4096 + ((f) >> 2) * 1024)); vhi[i] = vtr(vp_ + (((f) & 3) * 4096 + ((f) >> 2) * 1024 + 512)); } while (0)
#define GAPA(MF, A0, A1, A2, A3, W0, W1, PW) do { MF; sacc += A0; sacc += A1; sacc += A2; sacc += A3; PIN(sacc); W0; W1; PIN(PW); SBAR(); } while (0)
#define EXS(v) __builtin_amdgcn_exp2f((v) - msub)
#define GAPB(MF, X, B) do { MF; X[B] = EXS(X[B]); X[B + 1] = EXS(X[B + 1]); PIN(X); SBAR(); } while (0)
#define KRD(j) do { kload2(kf, kp0 + sn * 8192, j); SBAR(); } while (0)
#define MF32(a, b, cc) __builtin_amdgcn_mfma_f32_32x32x16_bf16(a, b, cc, 0, 0, 0)
#define STEP(C0, C1, P0, P1, t, NEARF) do { SBAR(); \
        ldscp vp_ = vp0 + sp * 16384; float msub; \
        VRD(0, 0); SBAR(); float sacc = (P0[0] + P0[1]); \
        GAPA(C0 = MF32(kf[0], qf[0], zero), P0[2], P0[3], P0[4], P0[5],     pw0[0] = PKW(P0, 0), pw0[1] = PKW(P0, 2), pw0); \
        VRD(1, 1); SBAR(); GAPA(C1 = MF32(kf[1], qf[0], zero), P0[6], P0[7], P0[8], P0[9],     pw0[2] = PKW(P0, 4), pw0[3] = PKW(P0, 6), pw0); \
        VRD(2, 2); SBAR(); GAPA(C0 = MF32(kf[2], qf[1], C0),   P0[10], P0[11], P0[12], P0[13], pw1[0] = PKW(P0, 8), pw1[1] = PKW(P0, 10), pw1); \
        VRD(3, 3); SBAR(); GAPA(C1 = MF32(kf[3], qf[1], C1),   P0[14], P0[15], P1[0], P1[1],   pw1[2] = PKW(P0, 12), pw1[3] = PKW(P0, 14), pw1); \
        VRD(4, 4); SBAR(); GAPA(C0 = MF32(kf[4], qf[2], C0),   P1[2], P1[3], P1[4], P1[5],     pw2[0] = PKW(P1, 0), pw2[1] = PKW(P1, 2), pw2); \
        VRD(5, 5); SBAR(); GAPA(C1 = MF32(kf[5], qf[2], C1),   P1[6], P1[7], P1[8], P1[9],     pw2[2] = PKW(P1, 4), pw2[3] = PKW(P1, 6), pw2); \
        VRD(6, 6); SBAR(); GAPA(C0 = MF32(kf[6], qf[3], C0),   P1[10], P1[11], P1[12], P1[13], pw3[0] = PKW(P1, 8), pw3[1] = PKW(P1, 10), pw3); \
        VRD(7, 7); SBAR(); GAPA(C1 = MF32(kf[7], qf[3], C1),   P1[14], P1[15], 0.f, 0.f,       pw3[2] = PKW(P1, 12), pw3[3] = PKW(P1, 14), pw3); \
        l_reg += sacc; \
        DMA_K((t) + 3, sc); DMA_V((t) + 1, sn); \
        if (NEARF) NEARFIX(C0, C1, t); \
        { const float bc_ = (NEARF && (t) >= NT - 4) ? 0.f : bfar; DECIDE(C0, C1, bc_, msub); } \
        SBAR(); \
        GAPB(o[0] = MF32(PAF(0), VFR(0), o[0]), C0, 0);  VRD(0, 8);  SBAR(); \
        GAPB(o[1] = MF32(PAF(0), VFR(1), o[1]), C0, 2);  VRD(1, 9);  SBAR(); \
        GAPB(o[2] = MF32(PAF(0), VFR(2), o[2]), C0, 4);  VRD(2, 10); SBAR(); \
        GAPB(o[3] = MF32(PAF(0), VFR(3), o[3]), C0, 6);  VRD(3, 11); SBAR(); \
        GAPB(o[0] = MF32(PAF(1), VFR(4), o[0]), C0, 8);  VRD(4, 12); SBAR(); \
        GAPB(o[1] = MF32(PAF(1), VFR(5), o[1]), C0, 10); VRD(5, 13); SBAR(); \
        GAPB(o[2] = MF32(PAF(1), VFR(6), o[2]), C0, 12); VRD(6, 14); SBAR(); \
        GAPB(o[3] = MF32(PAF(1), VFR(7), o[3]), C0, 14); VRD(7, 15); SBAR(); \
        GAPB(o[0] = MF32(PAF(2), VFR(0), o[0]), C1, 0); \
        GAPB(o[1] = MF32(PAF(2), VFR(1), o[1]), C1, 2); \
        KRD(0); GAPB(o[2] = MF32(PAF(2), VFR(2), o[2]), C1, 4); \
        KRD(1); GAPB(o[3] = MF32(PAF(2), VFR(3), o[3]), C1, 6); \
        KRD(2); GAPB(o[0] = MF32(PAF(3), VFR(4), o[0]), C1, 8); \
        KRD(3); GAPB(o[1] = MF32(PAF(3), VFR(5), o[1]), C1, 10); \
        GAPB(o[2] = MF32(PAF(3), VFR(6), o[2]), C1, 12); \
        GAPB(o[3] = MF32(PAF(3), VFR(7), o[3]), C1, 14); \
    } while (0)
    int t = 1;
    for (; t + 5 < NT; t += 2) {
        STEP(pB0, pB1, pA0, pA1, t, 0);     WAIT_BAR(4); RESC(); ROT();
        STEP(pA0, pA1, pB0, pB1, t + 1, 0); WAIT_BAR(4); RESC(); ROT();
    }
    for (; t + 1 < NT; t += 2) {
        STEP(pB0, pB1, pA0, pA1, t, 1);     WAIT_BAR(4); RESC(); ROT();
        STEP(pA0, pA1, pB0, pB1, t + 1, 1); WAIT_BAR(4); RESC(); ROT();
    }
    STEP(pB0, pB1, pA0, pA1, NT - 1, 1); WAIT_BAR(4); RESC();
    { float sacc = pB0[0] + pB0[1];
#pragma unroll
      for (int r = 2; r < 16; ++r) sacc += pB0[r];
#pragma unroll
      for (int r = 0; r < 16; ++r) sacc += pB1[r];
      l_reg += sacc;
      u32x4 pw[4]; packp(pw, pB0, pB1);
      ldscp vp_ = vp0 + sc * 16384;
      SBAR();
#pragma unroll
      for (int db = 0; db < 4; ++db) {
#pragma unroll
          for (int ks = 0; ks < 4; ++ks) { const bf16x8 vf = vfrag(vp_, db, ks); o[db] = MF32(__builtin_bit_cast(bf16x8, pw[ks]), vf, o[db]); }
          SBAR();
      } }
    asm volatile("s_waitcnt vmcnt(0) lgkmcnt(0)\n\ts_barrier" ::: "memory");
#undef TCL
#undef DMA_K
#undef DMA_V
#undef ROT
#undef NEARFIX
#undef MX3
#undef DECIDE
#undef RESC
#undef PKW
#undef PAF
#undef VFR
#undef VRD
#undef GAPA
#undef EXS
#undef GAPB
#undef KRD
#undef MF32
#undef STEP
    DiffState S; S.m = mhat; S.l = l_reg; S.o[0] = o[0]; S.o[1] = o[1]; S.o[2] = o[2]; S.o[3] = o[3];
    diff_finish(S, c, h, rowb + q0 + wq * 32, true);
}
#undef SBAR
#undef PIN
#undef WAIT_BAR

template <int NQ> __device__ __forceinline__ void band_unit(const Ctx& c0, int b, int ch) {
    Ctx c = c0; c.lane = pg8::lane_late(); c.tid = c.wid * 64 + c.lane; c.r32 = c.lane & 31; c.hi = c.lane >> 5;
    const int h = c.wid;
    constexpr bool SAMPLE = (NQ == 1);
    const size_t qrow0 = SAMPLE ? (size_t)MP + b * SS : (size_t)b * SEQ + ch * 64;
    LAS float* wsf = (LAS float*)(c.lds + L_WSF) + c.wid * 64;
    const LAS float* bt = (const LAS float*)(c.lds + L_BT) + h * 264;
    ldsp ks = c.lds + c.wid * 16384; ldsp vs = ks + 8192;
    bf16x8 qr[NQ][4]; float mh[NQ], l[NQ]; f32x16 o[NQ][2];
#pragma unroll
    for (int q = 0; q < NQ; ++q) {
        mh[q] = NEGBIG; l[q] = 0.f; o[q][0] = f32x16{}; o[q][1] = f32x16{};
        const bf16_t* qp = c.Z + (qrow0 + q * 32 + c.r32) * NZ + 1536 + h * 64;
#pragma unroll
        for (int d0 = 0; d0 < 4; ++d0) qr[q][d0] = *(const bf16x8*)(qp + d0 * 16 + c.hi * 8);
    }
    const int jt0 = SAMPLE ? 0 : (ch >= 8 ? 0 : 8 - ch);
    const f32x16 zero = f32x16{};
    for (int jt = jt0; jt <= 8; ++jt) {
        bool half = false;
        if (!SAMPLE || jt == 8) {
            const size_t krow0 = SAMPLE ? (size_t)MP + b * SS : (size_t)b * SEQ + (size_t)(ch - 8 + jt) * 64;
            if (SAMPLE) half = true;
#pragma unroll 2
            for (int p = 0; p < 8; ++p) {
                u32x4 kv = (u32x4){0u, 0u, 0u, 0u}, vv = kv;
                if (!SAMPLE || c.lane < 32) kv = *(const u32x4*)(c.Z + (krow0 + c.lane) * NZ + 2048 + h * 64 + p * 8);
                const int vk = 16 * (p & 3) + (c.lane >> 2);
                if (!SAMPLE || vk < 32) vv = *(const u32x4*)(c.Z + (krow0 + vk) * NZ + 2560 + h * 64 + (p >> 2) * 32 + (c.lane & 3) * 8);
                *(LAS u32x4*)(ks + p * 1024 + c.lane * 16) = kv; *(LAS u32x4*)(vs + p * 1024 + c.lane * 16) = vv;
            }
        } else {
#pragma unroll 4
            for (int p = 0; p < 8; ++p) {
                const float* kp = c.cbk + ((size_t)(b * CBL + jt * 64 + c.lane) * 8 + h) * 64 + p * 8;
                const float* vp = c.cbv + ((size_t)(b * CBL + jt * 64 + 16 * (p & 3) + (c.lane >> 2)) * 8 + h) * 64 + (p >> 2) * 32 + (c.lane & 3) * 8;
                *(LAS u32x4*)(ks + p * 1024 + c.lane * 16) = cvt8(*(const f32x4*)kp, *(const f32x4*)(kp + 4));
                *(LAS u32x4*)(vs + p * 1024 + c.lane * 16) = cvt8(*(const f32x4*)vp, *(const f32x4*)(vp + 4));
            }
        }
        __builtin_amdgcn_sched_barrier(0);
        u32x4 pw[NQ][4];
#pragma unroll
        for (int q = 0; q < NQ; ++q) {
            f32x16 p0, p1;
            qkt(p0, p1, ks, qr[q], zero, c.r32, c.hi);
            const int relb = SAMPLE ? (jt == 8 ? -c.r32 : 64 * jt - 512 - c.r32) : (jt - 8) * 64 - (q * 32 + c.r32);
            const int relh = relb + 4 * c.hi;
#pragma unroll
            for (int r = 0; r < 16; ++r) {
                int i0 = relh + crow0(r), i1 = relh + crow0(r) + 32;
                i0 = (i0 < -128 ? -128 : (i0 > 128 ? 128 : i0)) + 128; i1 = (i1 < -128 ? -128 : (i1 > 128 ? 128 : i1)) + 128;
                p0[r] += bt[i0]; p1[r] += bt[i1];
            }
            if (half) {
#pragma unroll
                for (int r = 0; r < 16; ++r) p1[r] = NEGBIG;
            }
            softmax_step<2>(p0, p1, mh[q], l[q], o[q], wsf, c.r32, c.hi, 0.f);
            packp(pw[q], p0, p1);
        }
        ldscp vp = vs + vlane_off(c.lane);
        __builtin_amdgcn_sched_barrier(0);
#pragma unroll
        for (int db = 0; db < 2; ++db) {
#pragma unroll
            for (int ksx = 0; ksx < 4; ++ksx) {
                const bf16x8 vf = vfrag(vp, db, ksx);
#pragma unroll
                for (int q = 0; q < NQ; ++q) o[q][db] = __builtin_amdgcn_mfma_f32_32x32x16_bf16(__builtin_bit_cast(bf16x8, pw[q][ksx]), vf, o[q][db], 0, 0, 0);
            }
            __builtin_amdgcn_sched_barrier(0);
        }
    }
    LAS float* xch = (LAS float*)(c.lds + L_XCH);
    float rl[NQ][16];
#pragma unroll
    for (int q = 0; q < NQ; ++q) {
        const float lt = l[q] + __shfl_xor(l[q], 32);
        if (c.hi == 0) wsf[c.r32] = 1.0f / lt;
#pragma unroll
        for (int r = 0; r < 16; ++r) rl[q][r] = (wsf + 4 * c.hi)[crow0(r)];
#pragma unroll
        for (int r = 0; r < 16; ++r) {
            o[q][0][r] *= rl[q][r]; o[q][1][r] *= rl[q][r];
            float ss = o[q][0][r] * o[q][0][r] + o[q][1][r] * o[q][1][r];
            ss += __shfl_xor(ss, 1); ss += __shfl_xor(ss, 2); ss += __shfl_xor(ss, 4); ss += __shfl_xor(ss, 8); ss += __shfl_xor(ss, 16);
            if (c.r32 == 0) (xch + (q * 32 + 4 * c.hi) * 8 + h)[crow0(r) * 8] = ss;
        }
    }
    __syncthreads();
    const float g0 = c.onb[h * 64 + c.r32], g1 = c.onb[h * 64 + 32 + c.r32];
#pragma unroll
    for (int q = 0; q < NQ; ++q)
#pragma unroll
        for (int r = 0; r < 16; ++r) {
            const LAS float* xr = xch + (q * 32 + 4 * c.hi) * 8 + crow0(r) * 8;
            const f32x4 a = *(const LAS f32x4*)(xr), bq = *(const LAS f32x4*)(xr + 4);
            const float tot = ((a[0] + a[1]) + (a[2] + a[3])) + ((bq[0] + bq[1]) + (bq[2] + bq[3]));
            const float rs = 1.0f / sqrtf(tot * (1.0f / 512.0f) + 1e-6f);
            bf16_t* op = c.AO + (qrow0 + q * 32 + 4 * c.hi) * DM + 512 + h * 64 + c.r32 + crow0(r) * DM;
            op[0] = (bf16_t)(cvtpk(o[q][0][r] * rs * g0, 0.f) & 0xffffu);
            op[32] = (bf16_t)(cvtpk(o[q][1][r] * rs * g1, 0.f) & 0xffffu);
        }
    __syncthreads();
}
#undef LAS
}

#define LAS __attribute__((address_space(3)))
typedef unsigned short bf16;
typedef float f32x4 __attribute__((ext_vector_type(4)));
typedef unsigned v4u __attribute__((ext_vector_type(4)));
constexpr int NWAVES = 8, NTHREADS = NWAVES * 64;
constexpr int LDS_BYTES = 155648;
constexpr int L_MISC = att::L_END;
static_assert(L_MISC + 64 <= LDS_BYTES, "LDS map");
constexpr size_t MiB = 1u << 20;
constexpr size_t WS_WIN = 0, WS_WOUT = 6 * MiB, WS_WUP = 8 * MiB, WS_WDN = 16 * MiB, WS_WG = 24 * MiB, WS_WP = 26 * MiB;
constexpr size_t WS_CTL = 26 * MiB + 512 * 1024, CTL_BYTES = 32768;
constexpr size_t WS_SS1 = 27 * MiB, WS_SS2 = 30 * MiB;
constexpr size_t WS_PB = 33 * MiB;
constexpr size_t WS_B = 50 * MiB;
constexpr size_t WS_C = 116 * MiB;
constexpr size_t WS_A = 182 * MiB;
constexpr size_t WS_END = WS_A + (size_t)MT * DFF * 2;
static_assert(WS_END <= 512 * MiB && WS_PB + (size_t)MT * DPLE * 2 <= WS_B && WS_B + (size_t)MT * DM * 2 <= WS_C && WS_C + (size_t)MT * DM * 2 <= WS_A && WS_SS2 + (size_t)MT * 64 <= WS_PB && (size_t)MP * DFF * 2 >= (size_t)MT * NZ * 2, "d_ws map");
constexpr int CW_BAR = 0;
constexpr int CW_QHEAD = 4096;
constexpr int CW_DEP = 4096 + 8 * 64;
static_assert((CW_DEP + 8 * 64) * 4 <= (int)CTL_BYTES, "control words");

#define XB_TMO      128
#define XB_XCNT(j)  (256  + 64 * (j))
#define XB_XSUB(j)  (1280 + 64 * (j))
#define XB_XGEN(j)  (2304 + 64 * (j))
#define XB_TOP      3328
#define XB_TOPGEN   3392
#define XCD_BAR_WORDS 3456
#define XB_SPIN_CAP (1u << 24)
__device__ __forceinline__ unsigned xb_ld(unsigned* p)              { return __hip_atomic_load(p, __ATOMIC_RELAXED, __HIP_MEMORY_SCOPE_AGENT); }
__device__ __forceinline__ unsigned xb_add(unsigned* p, unsigned v) { return __hip_atomic_fetch_add(p, v, __ATOMIC_RELAXED, __HIP_MEMORY_SCOPE_AGENT); }
__device__ __forceinline__ unsigned xb_xcc_id() { return (unsigned)__builtin_amdgcn_s_getreg((3 << 11) | 20) & 0xFu; }
#define XB_SPIN(cond, bar) do { unsigned _sp = 0; while (cond) { __builtin_amdgcn_s_sleep(1); \
    if ((++_sp & 255u) == 0u) { if (xb_ld(&(bar)[XB_TMO])) break; if (_sp > XB_SPIN_CAP) { atomicAdd(&(bar)[XB_TMO], 1u); break; } } } } while (0)
struct XcdBarrier { unsigned* bar; unsigned x; volatile LAS unsigned* st; };
__device__ __forceinline__ void xcd_barrier_complete(unsigned* bar, unsigned x, unsigned& nloc, unsigned& nx) {
    const unsigned G = gridDim.x;
    unsigned sum, cnt, mine, sp = 0u;
    for (;;) {
        sum = 0u; cnt = 0u; mine = 0u;
#pragma unroll
        for (unsigned j = 0; j < 16; ++j) { const unsigned c = xb_ld(&bar[XB_XCNT(j)]); sum += c; cnt += (c > 0u) ? 1u : 0u; mine = (j == x) ? c : mine; }
        if (sum == G) break;
        __builtin_amdgcn_s_sleep(1);
        if ((++sp & 255u) == 0u) { if (xb_ld(&bar[XB_TMO])) break; if (sp > XB_SPIN_CAP) { atomicAdd(&bar[XB_TMO], 1u); break; } }
    }
    nloc = mine > 0u ? mine : 1u; nx = cnt > 0u ? cnt : 1u;
}
__device__ __forceinline__ void xcd_barrier(const XcdBarrier& b, bool leader) {
    asm volatile("s_waitcnt vmcnt(0)" ::: "memory");
    __syncthreads();
    if (leader) {
        unsigned* bar = b.bar;
        __builtin_amdgcn_s_waitcnt(0);
        unsigned nloc = b.st[0], nx = b.st[1];
        if (nloc == 0u) { xcd_barrier_complete(bar, b.x, nloc, nx); b.st[0] = nloc; b.st[1] = nx; }
        const unsigned old = xb_add(&bar[XB_XSUB(b.x)], 1u);
        const unsigned gen = old / nloc;
        if (old + 1u == (gen + 1u) * nloc) {
            __builtin_amdgcn_fence(__ATOMIC_RELEASE, "agent");
            asm volatile("s_waitcnt vmcnt(0)" ::: "memory");
            const unsigned og = xb_add(&bar[XB_TOP], 1u);
            const unsigned tg = og / nx;
            if (og + 1u == (tg + 1u) * nx) xb_add(&bar[XB_TOPGEN], 1u);
            else XB_SPIN(xb_ld(&bar[XB_TOPGEN]) == tg, bar);
            __builtin_amdgcn_fence(__ATOMIC_ACQUIRE, "agent");
            xb_add(&bar[XB_XGEN(b.x)], 1u);
            asm volatile("s_waitcnt vmcnt(0)" ::: "memory");
        } else {
            XB_SPIN(xb_ld(&bar[XB_XGEN(b.x)]) == gen, bar);
            __builtin_amdgcn_fence(__ATOMIC_ACQUIRE, "agent");
            asm volatile("s_waitcnt vmcnt(0)" ::: "memory");
        }
    }
    __syncthreads();
}

struct Args {
    const float *xp, *xs, *cak, *cav, *cbk, *cbv, *pp, *ps, *t5, *g_attn, *w_in, *lq1, *lk1, *lq2, *lk2, *subln, *bandt, *onb, *w_out, *g_mlp, *w_up, *w_down, *w_gate, *w_proj, *g_final;
    float* out; unsigned char* ws;
};

__device__ __forceinline__ float wave_sum(float v) {
#pragma unroll
    for (int o = 1; o < 64; o <<= 1) v += __shfl_xor(v, o);
    return v;
}
__device__ __forceinline__ void p0_transpose_item(const float* W, int K, int N, bf16* WT, const float* kscale, LAS float* scr, int item, int lane) {
    const int nblk = N / 32, kb = item / nblk, nb = item % nblk, k0 = 64 * kb, n0 = 32 * nb;
#pragma unroll 8
    for (int i = 0; i < 32; ++i) { const int kk = 2 * i + (lane >> 5); float v = W[(size_t)(k0 + kk) * N + n0 + (lane & 31)]; if (kscale) v *= kscale[k0 + kk]; scr[kk * 33 + (lane & 31)] = v; }
    asm volatile("s_waitcnt lgkmcnt(0)" ::: "memory");
    const int c = lane & 7;
#pragma unroll
    for (int j = 0; j < 4; ++j) { const int n = (lane >> 3) + 8 * j; const LAS float* s = scr + (8 * c) * 33 + n;
        v4u o; o.x = pg8::cvt_pk_bf16(s[0 * 33], s[1 * 33]); o.y = pg8::cvt_pk_bf16(s[2 * 33], s[3 * 33]); o.z = pg8::cvt_pk_bf16(s[4 * 33], s[5 * 33]); o.w = pg8::cvt_pk_bf16(s[6 * 33], s[7 * 33]);
        *(v4u*)(WT + (size_t)(n0 + n) * K + k0 + 8 * c) = o; }
    asm volatile("s_waitcnt lgkmcnt(0)" ::: "memory");
}

enum : int { K_PROLOGUE = 0, K_QKV, K_OUT, K_UP, K_PP, K_DOWN, K_GATE, K_DIFF, K_BAND, K_SDIFF, K_SBAND, K_FINAL, K_BAR, K_QUEUE, K_END };
constexpr int Q_A = 0,   Q_B = 24,  Q_C = 280, Q_D = 360, Q_E = 616, Q_F = 624, Q_G = 880, Q_H = 920, Q_I = 1176, Q_J = 1184, Q_K = 1440, Q_L = 1448, Q_END = 1704, Q_LEN = Q_END / 8;
static_assert(Q_END % 8 == 0, "queue");

__global__ void __launch_bounds__(NTHREADS, 2) mk_fwd(Args a) {
    extern __shared__ __attribute__((aligned(16))) unsigned char lds_raw[];
    LAS unsigned char* lds = (LAS unsigned char*)lds_raw;
    const int G = gridDim.x, bid = blockIdx.x;
    const int wave = __builtin_amdgcn_readfirstlane(threadIdx.x >> 6);
    unsigned char* ws = a.ws;
    bf16 *Win_t = (bf16*)(ws + WS_WIN), *Wout_t = (bf16*)(ws + WS_WOUT), *Wup_t = (bf16*)(ws + WS_WUP), *Wdn_t = (bf16*)(ws + WS_WDN), *Wg_t = (bf16*)(ws + WS_WG), *Wp_t = (bf16*)(ws + WS_WP);
    float *SS1 = (float*)(ws + WS_SS1), *SS2 = (float*)(ws + WS_SS2);
    bf16 *PB = (bf16*)(ws + WS_PB), *XN = (bf16*)(ws + WS_B), *AO = (bf16*)(ws + WS_B), *PP = (bf16*)(ws + WS_B), *HB = (bf16*)(ws + WS_C), *Z = (bf16*)(ws + WS_A), *U = (bf16*)(ws + WS_A);
    float* Y = a.out + O_Y;
    unsigned* ctl = (unsigned*)(ws + WS_CTL);
    volatile LAS unsigned* misc = (volatile LAS unsigned*)(lds + L_MISC);
    XcdBarrier xbar; xbar.bar = ctl + CW_BAR; xbar.x = xb_xcc_id(); xbar.st = misc;
    { const int l0 = pg8::lane_late();
      if (wave == 0 && l0 < 4) misc[l0] = 0u;
      if (wave == 0 && l0 == 0) (void)xb_add(&xbar.bar[XB_XCNT(xbar.x)], 1u);
      __syncthreads(); }
#define LEADER() ((wave == 0) && (pg8::lane_late() == 0))

    constexpr int NPROG = 17;
    const int prog[NPROG] = {K_PROLOGUE, K_BAR, K_QKV, K_BAR, K_QUEUE, K_BAR, K_OUT, K_BAR, K_UP, K_PP, K_BAR, K_DOWN, K_BAR, K_GATE, K_BAR, K_FINAL, K_END};
    int pc = 0;
    bool att_ready = false;
    for (;;) {
        int kind = prog[pc];
        int row_off = 0, gM = MP, gG = G, gc = bid;
        int p0 = 0, p1 = 0, p2 = 0;
        int dep_wait = -1, dep_need = 0, dep_sig = -1;
        if (kind == K_QUEUE) {
            if (LEADER()) {
                int got = -1;
                for (int k = 0; k < 8 && got < 0; ++k) {
                    const int q = (int)((xbar.x + (unsigned)k) & 7u);
                    unsigned* hd = ctl + CW_QHEAD + 64 * q;
                    if (xb_ld(hd) < (unsigned)Q_LEN) { const unsigned i = xb_add(hd, 1u); if (i < (unsigned)Q_LEN) got = (int)i * 8 + q; }
                }
                misc[2] = (unsigned)got;
            }
            __syncthreads();
            const int g = (int)misc[2];
            __syncthreads();
            if (g < 0) { ++pc; continue; }
            if (g < Q_B)      { kind = K_QKV; row_off = MP; gM = MS; gG = 1 << 20; gc = g - Q_A; dep_sig = 0; }
            else if (g < Q_C) { const int k = g - Q_B; kind = K_DIFF; p0 = k & 7; p1 = 127 - (k >> 3); }
            else if (g < Q_D) { const int k = g - Q_C; dep_wait = 0; dep_need = 24; dep_sig = 1; if (k < 64) { kind = K_SDIFF; p0 = k >> 2; p1 = k & 3; } else { kind = K_SBAND; p0 = k - 64; } }
            else if (g < Q_E) { const int k = g - Q_D; kind = K_DIFF; p0 = k & 7; p1 = 95 - (k >> 3); }
            else if (g < Q_F) { kind = K_OUT; row_off = MP; gM = MS; gG = 1 << 20; gc = g - Q_E; dep_wait = 1; dep_need = 80; dep_sig = 2; }
            else if (g < Q_G) { const int k = g - Q_F; kind = K_BAND; p0 = 0; p1 = k; }
            else if (g < Q_H) { const int k = g - Q_G; row_off = MP; gM = MS; gG = 1 << 20; dep_wait = 2; dep_need = 8; dep_sig = 3; if (k < 32) { kind = K_UP; gc = k; } else { kind = K_PP; gc = k - 32; } }
            else if (g < Q_I) { const int k = g - Q_H; kind = K_DIFF; p0 = k & 7; p1 = 63 - (k >> 3); }
            else if (g < Q_J) { kind = K_DOWN; row_off = MP; gM = MS; gG = 1 << 20; gc = g - Q_I; dep_wait = 3; dep_need = 40; dep_sig = 4; }
            else if (g < Q_K) { const int k = g - Q_J; kind = K_BAND; p0 = 1; p1 = k; }
            else if (g < Q_L) { kind = K_GATE; row_off = MP; gM = MS; gG = 1 << 20; gc = g - Q_K; dep_wait = 4; dep_need = 8; }
            else              { const int k = g - Q_L; kind = K_DIFF; p0 = k & 7; p1 = 31 - (k >> 3); }
            if (dep_wait >= 0) {
                if (LEADER()) {
                    unsigned* cw = ctl + CW_DEP + 64 * dep_wait; unsigned sp = 0;
                    while (xb_ld(cw) < (unsigned)dep_need) { __builtin_amdgcn_s_sleep(2); if (++sp > XB_SPIN_CAP) break; }
                    __builtin_amdgcn_fence(__ATOMIC_ACQUIRE, "agent");
                    asm volatile("s_waitcnt vmcnt(0)" ::: "memory");
                }
                __syncthreads();
            }
        } else {
            ++pc;
        }
        const size_t aoff = (size_t)row_off;
        switch (kind) {
        case K_PROLOGUE: {
            const int lane = pg8::lane_late();
            LAS float* scr = (LAS float*)(lds + wave * 16384);
            const int gw = bid * NWAVES + wave, NGW = G * NWAVES;
            constexpr int I_IN = (DM / 64) * (NZ / 32), I_OUT = (DM / 64) * (DM / 32), I_UP = (DM / 64) * (DFF / 32), I_DN = (DFF / 64) * (DM / 32), I_G = I_OUT, I_P = (DPLE / 64) * (DM / 32);
            constexpr int NITEMS = I_IN + I_OUT + I_UP + I_DN + I_G + I_P;
            for (int it = gw; it < NITEMS; it += NGW) {
                int r = it;
                if (r < I_IN) { p0_transpose_item(a.w_in, DM, NZ, Win_t, nullptr, scr, r, lane); continue; } r -= I_IN;
                if (r < I_OUT) { p0_transpose_item(a.w_out, DM, DM, Wout_t, nullptr, scr, r, lane); continue; } r -= I_OUT;
                if (r < I_UP) { p0_transpose_item(a.w_up, DM, DFF, Wup_t, a.g_mlp, scr, r, lane); continue; } r -= I_UP;
                if (r < I_DN) { p0_transpose_item(a.w_down, DFF, DM, Wdn_t, nullptr, scr, r, lane); continue; } r -= I_DN;
                if (r < I_G) { p0_transpose_item(a.w_gate, DM, DM, Wg_t, nullptr, scr, r, lane); continue; } r -= I_G;
                p0_transpose_item(a.w_proj, DPLE, DM, Wp_t, nullptr, scr, r, lane);
            }
            for (int m = gw; m < MT; m += NGW) {
                const float* xr = m < MP ? a.xp + (size_t)m * DM : a.xs + (size_t)(m - MP) * DM;
                f32x4 v[4], g[4]; float s = 0.f;
#pragma unroll
                for (int j = 0; j < 4; ++j) { v[j] = ((const f32x4*)xr)[lane + 64 * j]; g[j] = ((const f32x4*)a.g_attn)[lane + 64 * j]; s += (v[j][0] * v[j][0] + v[j][1] * v[j][1]) + (v[j][2] * v[j][2] + v[j][3] * v[j][3]); }
                const float rstd = 1.0f / sqrtf(wave_sum(s) * (1.0f / DM) + 1e-6f);
                unsigned long long* o8 = (unsigned long long*)(XN + (size_t)m * DM);
#pragma unroll
                for (int j = 0; j < 4; ++j) o8[lane + 64 * j] = (unsigned long long)pg8::cvt_pk_bf16(v[j][0] * rstd * g[j][0], v[j][1] * rstd * g[j][1]) | ((unsigned long long)pg8::cvt_pk_bf16(v[j][2] * rstd * g[j][2], v[j][3] * rstd * g[j][3]) << 32);
                const float* pr = m < MP ? a.pp + (size_t)m * DPLE : a.ps + (size_t)(m - MP) * DPLE;
                const f32x4 pv = ((const f32x4*)pr)[lane];
                ((unsigned long long*)(PB + (size_t)m * DPLE))[lane] = (unsigned long long)pg8::cvt_pk_bf16(pv[0], pv[1]) | ((unsigned long long)pg8::cvt_pk_bf16(pv[2], pv[3]) << 32);
            }
        } break;
        case K_QKV: {
            pg8::Gemm g{XN + aoff * DM, Win_t, gM, NZ, DM}; pg8::StaticOrder S; S.init(gM, NZ, gG, gc);
            pg8::EpiQKV E{Z, a.out, row_off};
            pg8::gemm_phase<pg8::EpiQKV, pg8::StaticOrder, true, true>(lds, g, S, E, wave);
        } break;
        case K_OUT: {
            pg8::Gemm g{AO + aoff * DM, Wout_t, gM, DM, DM}; pg8::StaticOrder S; S.init(gM, DM, gG, gc);
            pg8::EpiOut E{a.xp, a.xs, Y, HB, SS1, row_off};
            pg8::gemm_phase<pg8::EpiOut, pg8::StaticOrder, true, true>(lds, g, S, E, wave);
        } break;
        case K_UP: {
            pg8::Gemm g{HB + aoff * DM, Wup_t, gM, DFF, DM}; pg8::StaticOrder S; S.init(gM, DFF, gG, gc);
            pg8::EpiUp E{U, SS1, row_off};
            pg8::gemm_phase<pg8::EpiUp, pg8::StaticOrder, true, true>(lds, g, S, E, wave);
        } break;
        case K_PP: {
            int kp = DPLE; asm volatile("" : "+s"(kp));
            pg8::Gemm g{PB + aoff * DPLE, Wp_t, gM, DM, kp}; pg8::StaticOrder S; S.init(gM, DM, gG, gc);
            pg8::EpiPP E{PP, row_off};
            pg8::gemm_phase<pg8::EpiPP, pg8::StaticOrder, true, true>(lds, g, S, E, wave);
        } break;
        case K_DOWN: {
            pg8::Gemm g{U + aoff * DFF, Wdn_t, gM, DM, DFF}; pg8::StaticOrder S; S.init(gM, DM, gG, gc);
            pg8::EpiDown E{Y, HB, row_off};
            pg8::gemm_phase<pg8::EpiDown, pg8::StaticOrder, true, true>(lds, g, S, E, wave);
        } break;
        case K_GATE: {
            pg8::Gemm g{HB + aoff * DM, Wg_t, gM, DM, DM}; pg8::StaticOrder S; S.init(gM, DM, gG, gc);
            pg8::EpiGate E{Y, PP, SS2, row_off};
            pg8::gemm_phase<pg8::EpiGate, pg8::StaticOrder, true, true>(lds, g, S, E, wave);
        } break;
        case K_DIFF: case K_BAND: case K_SDIFF: case K_SBAND: {
            att::Ctx c; c.Z = Z; c.AO = AO; c.cak = a.cak; c.cav = a.cav; c.cbk = a.cbk; c.cbv = a.cbv; c.subln_g = a.subln; c.onb = a.onb;
            c.lds = lds; c.wid = wave; c.lane = 0; c.tid = 0; c.r32 = 0; c.hi = 0;
            if (!att_ready) {
                const int tid = wave * 64 + pg8::lane_late();
                for (int i = tid; i < 4 * 512; i += NTHREADS) { const int h = i >> 9, rel = (i & 511) - 448; ((LAS float*)(lds + att::L_T5))[i] = LOG2E * a.t5[att::t5_bucket(rel) * 4 + h]; }
                for (int i = tid; i < 8 * 264; i += NTHREADS) { const int h = i / 264, j = i % 264; ((LAS float*)(lds + att::L_BT))[i] = j <= 256 ? LOG2E * a.bandt[j * 8 + h] : 0.f; }
                if (tid == 0) { float d1 = 0.f, d2 = 0.f;
                    for (int i = 0; i < 64; ++i) { d1 += a.lq1[i] * a.lk1[i]; d2 += a.lq2[i] * a.lk2[i]; }
                    misc[3] = __float_as_uint(expf(d1) - expf(d2) + 0.2f); }
                att_ready = true;
                __syncthreads();
            }
            c.lam = __uint_as_float(misc[3]);
            if (kind == K_DIFF) att::diff_prompt_unit2(c, p0 >> 2, p0 & 3, p1);
            else if (kind == K_BAND) att::band_unit<2>(c, p0, p1);
            else if (kind == K_SDIFF) att::diff_sample_unit(c, p0, p1);
            else att::band_unit<1>(c, p0, 0);
        } break;
        case K_FINAL: {
            const int lane = pg8::lane_late();
            const int gw = bid * NWAVES + wave, NGW = G * NWAVES;
            for (int m = gw; m < MT; m += NGW) {
                float* yr = Y + (size_t)m * DM;
                const float sv = lane < 16 ? SS2[(size_t)m * 16 + lane] : 0.f;
                const float rstd = 1.0f / sqrtf(wave_sum(sv) * (1.0f / DM) + 1e-6f);
#pragma unroll
                for (int j = 0; j < 4; ++j) { const f32x4 v = ((const f32x4*)yr)[lane + 64 * j], g = ((const f32x4*)a.g_final)[lane + 64 * j]; ((f32x4*)yr)[lane + 64 * j] = v * rstd * g; }
            }
        } break;
        case K_BAR: { const bool ldr_ = LEADER(); xcd_barrier(xbar, ldr_); } break;
        default: return;
        }
        if (dep_sig >= 0) {
            asm volatile("s_waitcnt vmcnt(0)" ::: "memory");
            __syncthreads();
            if (LEADER()) {
                __builtin_amdgcn_fence(__ATOMIC_RELEASE, "agent");
                asm volatile("s_waitcnt vmcnt(0)" ::: "memory");
                (void)xb_add(ctl + CW_DEP + 64 * dep_sig, 1u);
            }
        }
    }
}

extern "C" void kernel_launch(void* const* d_in, const int* in_sizes, int n_in, void* d_out, int out_size, void* d_ws, size_t ws_size, hipStream_t stream) {
    static int grid = 0;
    if (grid == 0) {
        if (n_in != 25 || (size_t)out_size != O_END || ws_size < WS_END) { fprintf(stderr, "kernel_launch: unexpected sizes n_in %d out %d ws %zu\n", n_in, out_size, ws_size); grid = -1; return; }
        int dev = 0, cus = 0, per_cu = 0;
        if (hipGetDevice(&dev) != hipSuccess || hipDeviceGetAttribute(&cus, hipDeviceAttributeMultiprocessorCount, dev) != hipSuccess) { grid = -1; return; }
        if (hipFuncSetAttribute((const void*)mk_fwd, hipFuncAttributeMaxDynamicSharedMemorySize, LDS_BYTES) != hipSuccess) { fprintf(stderr, "kernel_launch: hipFuncSetAttribute failed\n"); grid = -1; return; }
        if (hipOccupancyMaxActiveBlocksPerMultiprocessor(&per_cu, (const void*)mk_fwd, NTHREADS, LDS_BYTES) != hipSuccess || per_cu < 1) { fprintf(stderr, "kernel_launch: occupancy query says %d\n", per_cu); (void)hipGetLastError(); per_cu = 1; }
        grid = cus;
    }
    if (grid < 0) return;
    Args a{};
    const float** f = (const float**)&a.xp;
    for (int i = 0; i < 25; ++i) f[i] = (const float*)d_in[i];
    a.out = (float*)d_out; a.ws = (unsigned char*)d_ws;
    if (hipMemsetAsync((char*)d_ws + WS_CTL, 0, CTL_BYTES, stream) != hipSuccess) { fprintf(stderr, "kernel_launch: memset failed\n"); return; }
    hipLaunchKernelGGL(mk_fwd, dim3(grid), dim3(NTHREADS), LDS_BYTES, stream, a);
}
```
